# Optimizing an MI355X kernel written in HIP

```python
import math
import jax, jax.numpy as jnp
from jax import lax
import numpy as np

D_MODEL = 2048
BATCH = 4
SEQ = 4096
DEPTH = 2

HEAD_DIM = 128
N_HEADS_TOTAL = D_MODEL // HEAD_DIM
N_FOX = N_HEADS_TOTAL // 2
N_DIFF = N_HEADS_TOTAL - N_FOX
FOX_WIDTH = N_FOX * HEAD_DIM
DIFF_WIDTH = N_DIFF * HEAD_DIM
MIX_WIDTH = FOX_WIDTH + DIFF_WIDTH
DIFF_QK_DIM = HEAD_DIM // 2
D_FF = 4 * D_MODEL
ROPE_THETA = 500000.0
ROT_DIM = DIFF_QK_DIM // 4
BLOCK_Q = 128
ALPHA = (2.0 * DEPTH) ** 0.25
BETA = (8.0 * DEPTH) ** -0.25
LN_EPS = 1e-5
RMS_EPS = 1e-5
ADA_SCALE = 0.5

_SIZES = [FOX_WIDTH, FOX_WIDTH, FOX_WIDTH, N_FOX, DIFF_WIDTH, DIFF_WIDTH, DIFF_WIDTH]
IN_COLS = sum(_SIZES)
_SPLITS = [int(v) for v in np.cumsum(_SIZES)[:-1]]

kernel_name = "hybrid_fox_diffattn_deepnorm_adaln"


def _layernorm(x, g, b):
    xf = x.astype(jnp.float32)
    mu = jnp.mean(xf, axis=-1, keepdims=True)
    var = jnp.mean(jnp.square(xf - mu), axis=-1, keepdims=True)
    y = (xf - mu) * lax.rsqrt(var + LN_EPS) * g.astype(jnp.float32) + b.astype(jnp.float32)
    return y.astype(x.dtype)


def _rope(x, cos, sin):
    half = ROT_DIM // 2
    c = cos[:, :, None, None, :]
    s = sin[:, :, None, None, :]
    x1 = x[..., :half]
    x2 = x[..., half:ROT_DIM]
    return jnp.concatenate([x1 * c - x2 * s, x2 * c + x1 * s, x[..., ROT_DIM:]], axis=-1)


def _lambda_init(layer_idx):
    return 0.8 - 0.6 * math.exp(-0.3 * layer_idx)


def _mixer(h, cos, sin, w_in, b_f, lq1, lk1, lq2, lk2, subln_g, w_o, lam_init):
    B, S, _ = h.shape
    f32 = jnp.float32
    proj = (h @ w_in).astype(f32)
    fq, fk, fv, ff, dq, dk, dv = jnp.split(proj, _SPLITS, axis=-1)
    fq = fq.reshape(B, S, N_FOX, HEAD_DIM)
    fk = fk.reshape(B, S, N_FOX, HEAD_DIM)
    fv = fv.reshape(B, S, N_FOX, HEAD_DIM)
    log_f = jax.nn.log_sigmoid(ff + b_f.astype(f32))
    fcum = jnp.cumsum(log_f, axis=1).transpose(0, 2, 1)
    dq = _rope(dq.reshape(B, S, N_DIFF, 2, DIFF_QK_DIM), cos, sin)
    dk = _rope(dk.reshape(B, S, N_DIFF, 2, DIFF_QK_DIM), cos, sin)
    dv = dv.reshape(B, S, N_DIFF, HEAD_DIM)
    lam = (jnp.exp(jnp.sum(lq1.astype(f32) * lk1.astype(f32)))
           - jnp.exp(jnp.sum(lq2.astype(f32) * lk2.astype(f32))) + lam_init)
    fox_scale = HEAD_DIM ** -0.5
    diff_scale = DIFF_QK_DIM ** -0.5
    key_pos = jnp.arange(S)

    def block(i):
        start = i * BLOCK_Q
        q_pos = start + jnp.arange(BLOCK_Q)
        causal = key_pos[None, :] <= q_pos[:, None]
        fq_b = lax.dynamic_slice_in_dim(fq, start, BLOCK_Q, axis=1)
        fc_b = lax.dynamic_slice_in_dim(fcum, start, BLOCK_Q, axis=2)
        s1 = (jnp.einsum('bqhd,bkhd->bhqk', fq_b, fk) * fox_scale
              + fc_b[:, :, :, None] - fcum[:, :, None, :])
        p1 = jax.nn.softmax(jnp.where(causal, s1, -jnp.inf), axis=-1)
        fox_o = jnp.einsum('bhqk,bkhd->bqhd', p1, fv)
        dq_b = lax.dynamic_slice_in_dim(dq, start, BLOCK_Q, axis=1)
        s2 = jnp.einsum('bqhcd,bkhcd->bhcqk', dq_b, dk) * diff_scale
        p2 = jax.nn.softmax(jnp.where(causal, s2, -jnp.inf), axis=-1)
        a = p2[:, :, 0] - lam * p2[:, :, 1]
        diff_o = jnp.einsum('bhqk,bkhd->bqhd', a, dv)
        return fox_o, diff_o

    fox_o, diff_o = lax.map(block, jnp.arange(S // BLOCK_Q))
    fox_o = jnp.moveaxis(fox_o, 0, 1).reshape(B, S, FOX_WIDTH)
    diff_o = jnp.moveaxis(diff_o, 0, 1).reshape(B, S, N_DIFF, HEAD_DIM)
    diff_o = diff_o * lax.rsqrt(jnp.mean(jnp.square(diff_o), axis=-1, keepdims=True) + RMS_EPS)
    diff_o = (diff_o * subln_g.astype(f32) * (1.0 - lam_init)).reshape(B, S, DIFF_WIDTH)
    mixed = jnp.concatenate([fox_o, diff_o], axis=-1).astype(h.dtype)
    return mixed @ w_o


def _mlp(h, w_up, w_down):
    return jnp.square(jax.nn.relu(h @ w_up)) @ w_down


def setup_inputs(seed: int = 0) -> dict:
    key = jax.random.key(seed)
    ks = jax.random.split(key, 20)
    f32 = jnp.float32
    x = jax.random.normal(ks[0], (BATCH, SEQ, D_MODEL), f32)
    c = jax.random.normal(ks[1], (BATCH, D_MODEL), f32)
    positions = jnp.broadcast_to(jnp.arange(SEQ, dtype=jnp.int32)[None, :], (BATCH, SEQ))
    w_ada = jax.random.normal(ks[2], (DEPTH, D_MODEL, 6 * D_MODEL), f32) * (ADA_SCALE * D_MODEL ** -0.5)
    b_ada = jax.random.normal(ks[3], (DEPTH, 6 * D_MODEL), f32) * 0.02
    col_scale = jnp.concatenate([
        jnp.ones((2 * FOX_WIDTH,), f32), jnp.full((FOX_WIDTH,), BETA, f32),
        jnp.ones((N_FOX + 2 * DIFF_WIDTH,), f32), jnp.full((DIFF_WIDTH,), BETA, f32)])
    w_in = jax.random.normal(ks[4], (DEPTH, D_MODEL, IN_COLS), f32) * (D_MODEL ** -0.5) * col_scale
    b_f = 2.0 + 0.5 * jax.random.normal(ks[5], (DEPTH, N_FOX), f32)
    lambda_q1 = jax.random.normal(ks[6], (DEPTH, DIFF_QK_DIM), f32) * 0.1
    lambda_k1 = jax.random.normal(ks[7], (DEPTH, DIFF_QK_DIM), f32) * 0.1
    lambda_q2 = jax.random.normal(ks[8], (DEPTH, DIFF_QK_DIM), f32) * 0.1
    lambda_k2 = jax.random.normal(ks[9], (DEPTH, DIFF_QK_DIM), f32) * 0.1
    subln_g = 1.0 + 0.02 * jax.random.normal(ks[10], (DEPTH, HEAD_DIM), f32)
    w_o = jax.random.normal(ks[11], (DEPTH, MIX_WIDTH, D_MODEL), f32) * (MIX_WIDTH ** -0.5) * BETA
    ln1_g = 1.0 + 0.02 * jax.random.normal(ks[12], (DEPTH, D_MODEL), f32)
    ln1_b = 0.02 * jax.random.normal(ks[13], (DEPTH, D_MODEL), f32)
    w_up = jax.random.normal(ks[14], (DEPTH, D_MODEL, D_FF), f32) * (D_MODEL ** -0.5)
    w_down = jax.random.normal(ks[15], (DEPTH, D_FF, D_MODEL), f32) * (D_FF ** -0.5) * BETA
    ln2_g = 1.0 + 0.02 * jax.random.normal(ks[16], (DEPTH, D_MODEL), f32)
    ln2_b = 0.02 * jax.random.normal(ks[17], (DEPTH, D_MODEL), f32)
    return {"x": x, "c": c, "positions": positions, "w_ada": w_ada, "b_ada": b_ada,
            "w_in": w_in, "b_f": b_f, "lambda_q1": lambda_q1, "lambda_k1": lambda_k1,
            "lambda_q2": lambda_q2, "lambda_k2": lambda_k2, "subln_g": subln_g,
            "w_o": w_o, "ln1_g": ln1_g, "ln1_b": ln1_b, "w_up": w_up, "w_down": w_down,
            "ln2_g": ln2_g, "ln2_b": ln2_b}


def reference(x, c, positions, w_ada, b_ada, w_in, b_f, lambda_q1, lambda_k1,
              lambda_q2, lambda_k2, subln_g, w_o, ln1_g, ln1_b, w_up, w_down,
              ln2_g, ln2_b):
    inv_freq = ROPE_THETA ** (-jnp.arange(0, ROT_DIM, 2, dtype=jnp.float32) / ROT_DIM)
    ang = positions.astype(jnp.float32)[:, :, None] * inv_freq
    cos, sin = jnp.cos(ang), jnp.sin(ang)
    c_act = jax.nn.silu(c)
    for l in range(DEPTH):
        mod = c_act @ w_ada[l] + b_ada[l]
        sh_a, sc_a, g_a, sh_m, sc_m, g_m = jnp.split(mod[:, None, :], 6, axis=-1)
        h = x * (1.0 + sc_a) + sh_a
        y = _mixer(h, cos, sin, w_in[l], b_f[l], lambda_q1[l], lambda_k1[l],
                   lambda_q2[l], lambda_k2[l], subln_g[l], w_o[l], _lambda_init(l))
        x = _layernorm(ALPHA * x + (1.0 + g_a) * y, ln1_g[l], ln1_b[l])
        h = x * (1.0 + sc_m) + sh_m
        y = _mlp(h, w_up[l], w_down[l])
        x = _layernorm(ALPHA * x + (1.0 + g_m) * y, ln2_g[l], ln2_b[l])
    return x
```

```cpp
#include <hip/hip_runtime.h>
#include <hip/hip_cooperative_groups.h>
#include <cstdio>
#include <cstdint>
namespace cg = cooperative_groups;
__device__ __forceinline__ int ltid() { int t = threadIdx.x; asm volatile("" : "+v"(t)); return t; }
namespace pg8 {
#define PG8_LAS __attribute__((address_space(3)))
typedef unsigned short bf16_t;
typedef short bf16x8 __attribute__((ext_vector_type(8)));
typedef float f32x4 __attribute__((ext_vector_type(4)));
typedef unsigned u32x4 __attribute__((ext_vector_type(4)));
constexpr int BM = 256, BK = 64, HALF = 128, HTB = HALF * BK * 2  , STAGE_BYTES = 8 * HTB, NXCD = 8, WGM = 8;

__host__ __device__ __forceinline__ int lds_byte(int r, int c) { const int st = (r >> 4) * 2 + (c >> 5), rr = r & 15, cc = c & 31, ob = rr * 64 + cc * 2; return st * 1024 + (ob ^ (((ob >> 9) & 1) << 5)); }
__host__ __device__ __forceinline__ void stage_rc(int b, int& R, int& C) { const int st = b / 1024, sb = b % 1024, swz = sb ^ (((sb >> 9) & 1) << 5); R = (st >> 1) * 16 + swz / 64; C = (st & 1) * 32 + (swz % 64) / 2; }
__host__ __device__ __forceinline__ int perm32(int rho) { const int n = rho >> 4, i = rho & 15; return 8 * (i >> 2) + 4 * n + (i & 3); }

struct Unit { int pm, pn; };
struct Gemm { const bf16_t* A; const bf16_t* Bt; int M, N, K; };

struct StaticOrder {
    int nM, nN, nwg, G, c;
    __host__ __device__ void init(int M, int N, int G_, int c_) { nM = M / BM; nN = N / BM; nwg = nM * nN; G = G_; c = c_; }
    __host__ __device__ bool next(int i, Unit& u) const {
        const long L = (long)i * G + c; if (L >= nwg) return false;
        int wgid = (int)L; { const int q = nwg / NXCD, r = nwg % NXCD, xcd = wgid % NXCD, off = wgid / NXCD; wgid = (xcd < r ? xcd * (q + 1) : r * (q + 1) + (xcd - r) * q) + off; }
        const int nig = WGM * nN, gid = wgid / nig, fm = gid * WGM, gsz = (nM - fm) < WGM ? (nM - fm) : WGM;
        u.pm = fm + ((wgid % nig) % gsz); u.pn = (wgid % nig) / gsz; return true;
    }
    __device__ __forceinline__ void a_ready(const Unit&) const {}
    __device__ __forceinline__ void done(const Unit&) const {}
};
__device__ __forceinline__ unsigned cvt_pk_bf16(float lo, float hi) { unsigned r; asm volatile("v_cvt_pk_bf16_f32 %0, %1, %2" : "=v"(r) : "v"(lo), "v"(hi)); return r; }
typedef float f32x2 __attribute__((ext_vector_type(2)));
template <class Epi, class Sched, bool ALIGN_EPI = false, bool SP2 = false>
__device__ __forceinline__ void gemm_phase(PG8_LAS unsigned char* lds, const Gemm g, const Sched& S, const Epi& E) {
    const int tid = ltid(), wid = __builtin_amdgcn_readfirstlane(tid >> 6), lane = tid & 63, wr = wid >> 2, wc = wid & 3, fr = lane & 15, fq = lane >> 4;
    const int K = g.K, nt = K / BK;
    unsigned voffA[2], voffB[2];
#pragma unroll
    for (int i = 0; i < 2; ++i) { int R, C; stage_rc(tid * 16 + i * 8192, R, C); const int Rb = Epi::PERM ? ((R & ~31) + perm32(R & 31)) : R;
        voffA[i] = (unsigned)(R * K + C) * 2u; voffB[i] = (unsigned)(Rb * K + C) * 2u; }
    const size_t kstep = (size_t)(BK * 2);
    const size_t hstep = (size_t)HALF * K * 2;
    const size_t tstep = 2 * hstep;
    const unsigned ldsw = (unsigned)wid * 1024u;
    const int aoff = lds_byte(wr * 64 + fr, fq * 8), boff = lds_byte(wc * 32 + fr, fq * 8);
#define PG8_SA(b, h) (((b) * 2 + (h)) * HTB)
#define PG8_SB(b, h) ((4 + (b) * 2 + (h)) * HTB)
#define PG8_STAGE(bufoff, gbase, voff) do { _Pragma("unroll") for (int _i = 0; _i < 2; ++_i) \
        __builtin_amdgcn_global_load_lds((const unsigned*)((const char*)(gbase) + (voff)[_i]), (PG8_LAS unsigned*)(lds + (bufoff) + ldsw + _i * 8192), 16, 0, 0); } while (0)
#define PG8_LDA(dst, b, h) do { _Pragma("unroll") for (int m = 0; m < 4; ++m) _Pragma("unroll") for (int k = 0; k < 2; ++k) dst[m][k] = *(const PG8_LAS bf16x8*)(lds + PG8_SA(b, h) + aoff + m * 2048 + k * 1024); } while (0)
#define PG8_LDB(dst, b, h) do { _Pragma("unroll") for (int n = 0; n < 2; ++n) _Pragma("unroll") for (int k = 0; k < 2; ++k) dst[n][k] = *(const PG8_LAS bf16x8*)(lds + PG8_SB(b, h) + boff + n * 2048 + k * 1024); } while (0)
#define PG8_MMA(ai, bj, At, Bt) do { __builtin_amdgcn_s_setprio(0); _Pragma("unroll") for (int m = 0; m < 4; ++m) _Pragma("unroll") for (int n = 0; n < 2; ++n) _Pragma("unroll") for (int k = 0; k < 2; ++k) \
        acc[ai][bj][m][n] = __builtin_amdgcn_mfma_f32_16x16x32_bf16(Bt[n][k], At[m][k], acc[ai][bj][m][n], 0, 0, 0); __builtin_amdgcn_s_setprio(0); } while (0)
#define PG8_WAIT_V(n) asm volatile("s_waitcnt vmcnt(" #n ")" ::: "memory")
#define PG8_WAIT_L(n) asm volatile("s_waitcnt lgkmcnt(" #n ")" ::: "memory")
#define PG8_BAR __builtin_amdgcn_s_barrier()
#define PG8_SCHED __builtin_amdgcn_sched_barrier(0)
    Unit cur, nxt; int ui = 0;
    if (!S.next(0, cur)) return;
    f32x4 acc[2][2][4][2];
#pragma unroll
    for (int a = 0; a < 2; ++a)
#pragma unroll
        for (int b = 0; b < 2; ++b)
#pragma unroll
            for (int m = 0; m < 4; ++m)
#pragma unroll
                for (int n = 0; n < 2; ++n) acc[a][b][m][n] = (f32x4){0.f, 0.f, 0.f, 0.f};
    bf16x8 At[4][2], B0[2][2], B1[2][2];
    const char* cA = (const char*)g.A + (size_t)cur.pm * tstep; const char* cB = (const char*)g.Bt + (size_t)cur.pn * tstep;
    S.a_ready(cur);
    if constexpr (SP2) {
        PG8_STAGE(PG8_SB(0, 0), cB, voffB); PG8_STAGE(PG8_SB(0, 1), cB + hstep, voffB); PG8_STAGE(PG8_SA(0, 0), cA, voffA); PG8_STAGE(PG8_SA(0, 1), cA + hstep, voffA);
        if (wr == 1) PG8_BAR;
        PG8_WAIT_V(2); PG8_BAR;
        PG8_STAGE(PG8_SB(1, 0), cB + kstep, voffB); PG8_STAGE(PG8_SA(1, 0), cA + kstep, voffA); PG8_STAGE(PG8_SB(1, 1), cB + hstep + kstep, voffB);
        PG8_WAIT_V(6); PG8_BAR;
    } else {
        PG8_STAGE(PG8_SB(0, 0), cB, voffB); PG8_STAGE(PG8_SA(0, 0), cA, voffA); PG8_STAGE(PG8_SB(0, 1), cB + hstep, voffB); PG8_STAGE(PG8_SA(0, 1), cA + hstep, voffA);
        if (wr == 1) PG8_BAR;
        PG8_WAIT_V(4); PG8_BAR;
        PG8_STAGE(PG8_SB(1, 0), cB + kstep, voffB); PG8_STAGE(PG8_SA(1, 0), cA + kstep, voffA); PG8_STAGE(PG8_SB(1, 1), cB + hstep + kstep, voffB);
        PG8_WAIT_V(6); PG8_BAR;
    }
    for (;;) {
        const bool has_next = S.next(ui + 1, nxt);
        const char* nA = has_next ? (const char*)g.A + (size_t)nxt.pm * tstep : cA; const char* nB = has_next ? (const char*)g.Bt + (size_t)nxt.pn * tstep : cB;
        for (int t = 0; t < nt; t += 2) {
            const bool last = (t == nt - 2);
            const char* a1 = cA + (size_t)(t + 1) * kstep;
            const char* a2 = last ? nA : cA + (size_t)(t + 2) * kstep; const char* b2 = last ? nB : cB + (size_t)(t + 2) * kstep;
            const char* a3 = a2 + kstep; const char* b3 = b2 + kstep;
            if (last && has_next) S.a_ready(nxt);
            if constexpr (SP2) {
            PG8_LDB(B0, 0, 0); PG8_LDB(B1, 0, 1); PG8_SCHED; PG8_LDA(At, 0, 0); PG8_STAGE(PG8_SA(1, 1), a1 + hstep, voffA);
            PG8_WAIT_V(8); PG8_WAIT_L(0); PG8_BAR; PG8_MMA(0, 0, At, B0); PG8_MMA(0, 1, At, B1); PG8_BAR; PG8_SCHED;
            PG8_LDA(At, 0, 1); PG8_STAGE(PG8_SB(0, 0), b2, voffB); PG8_STAGE(PG8_SB(0, 1), b2 + hstep, voffB); PG8_STAGE(PG8_SA(0, 0), a2, voffA);
            PG8_WAIT_V(8); PG8_WAIT_L(0); PG8_BAR; PG8_MMA(1, 0, At, B0); PG8_MMA(1, 1, At, B1); PG8_BAR; PG8_SCHED;
            PG8_LDB(B0, 1, 0); PG8_LDB(B1, 1, 1); PG8_SCHED; PG8_LDA(At, 1, 0); PG8_STAGE(PG8_SA(0, 1), a2 + hstep, voffA);
            PG8_WAIT_V(8); PG8_WAIT_L(0); PG8_BAR; PG8_MMA(0, 0, At, B0); PG8_MMA(0, 1, At, B1); PG8_BAR; PG8_SCHED;
            PG8_LDA(At, 1, 1); PG8_STAGE(PG8_SB(1, 0), b3, voffB); PG8_STAGE(PG8_SB(1, 1), b3 + hstep, voffB); PG8_STAGE(PG8_SA(1, 0), a3, voffA);
            PG8_WAIT_V(8); PG8_WAIT_L(0); PG8_BAR; PG8_MMA(1, 0, At, B0); PG8_MMA(1, 1, At, B1); PG8_BAR; PG8_SCHED;
            } else {
            PG8_LDB(B0, 0, 0); PG8_SCHED; PG8_LDA(At, 0, 0); PG8_STAGE(PG8_SA(1, 1), a1 + hstep, voffA);
            PG8_WAIT_L(8); PG8_BAR; PG8_WAIT_L(0); PG8_MMA(0, 0, At, B0); PG8_BAR; PG8_SCHED;
            PG8_LDB(B1, 0, 1); PG8_STAGE(PG8_SB(0, 0), b2, voffB);
            PG8_BAR; PG8_WAIT_L(0); PG8_MMA(0, 1, At, B1); PG8_BAR;
            PG8_LDA(At, 0, 1); PG8_STAGE(PG8_SA(0, 0), a2, voffA);
            PG8_BAR; PG8_WAIT_L(0); PG8_MMA(1, 0, At, B0); PG8_BAR; PG8_SCHED;
            PG8_STAGE(PG8_SB(0, 1), b2 + hstep, voffB);
            PG8_WAIT_V(6); PG8_BAR; PG8_MMA(1, 1, At, B1); PG8_BAR;
            PG8_LDB(B0, 1, 0); PG8_SCHED; PG8_LDA(At, 1, 0); PG8_STAGE(PG8_SA(0, 1), a2 + hstep, voffA);
            PG8_WAIT_L(8); PG8_BAR; PG8_WAIT_L(0); PG8_MMA(0, 0, At, B0); PG8_BAR; PG8_SCHED;
            PG8_LDB(B1, 1, 1); PG8_STAGE(PG8_SB(1, 0), b3, voffB);
            PG8_BAR; PG8_WAIT_L(0); PG8_MMA(0, 1, At, B1); PG8_BAR;
            PG8_LDA(At, 1, 1); PG8_STAGE(PG8_SA(1, 0), a3, voffA);
            PG8_BAR; PG8_WAIT_L(0); PG8_MMA(1, 0, At, B0); PG8_BAR; PG8_SCHED;
            PG8_STAGE(PG8_SB(1, 1), b3 + hstep, voffB);
            PG8_WAIT_V(6); PG8_BAR; PG8_MMA(1, 1, At, B1); PG8_BAR;
            }
        }
        if constexpr (ALIGN_EPI) { if (wr == 0) PG8_BAR; }
        if constexpr (!Epi::AFTER_DRAIN) { E(acc, cur, wr, wc, fr, fq); S.done(cur); }
        if (!has_next) break;
#pragma unroll
        for (int a = 0; a < 2; ++a)
#pragma unroll
            for (int b = 0; b < 2; ++b)
#pragma unroll
                for (int m = 0; m < 4; ++m)
#pragma unroll
                    for (int n = 0; n < 2; ++n) acc[a][b][m][n] = (f32x4){0.f, 0.f, 0.f, 0.f};
        cur = nxt; cA = nA; cB = nB; ++ui;
        if constexpr (ALIGN_EPI) { if (wr == 1) PG8_BAR; }
    }
    PG8_WAIT_V(0);
    if constexpr (!ALIGN_EPI) { if (wr == 0) PG8_BAR; }
    PG8_BAR;
    if constexpr (Epi::AFTER_DRAIN) { E.fused(acc, cur, wr, wc, fr, fq, lds, wid, lane); S.done(cur); }
#undef PG8_SA
#undef PG8_SB
#undef PG8_STAGE
#undef PG8_LDA
#undef PG8_LDB
#undef PG8_MMA
#undef PG8_WAIT_V
#undef PG8_WAIT_L
#undef PG8_BAR
#undef PG8_SCHED
}
}

namespace att {
typedef unsigned short bf16;
typedef short bf16x8 __attribute__((ext_vector_type(8)));
typedef short s16x4 __attribute__((ext_vector_type(4)));
typedef float f32x16 __attribute__((ext_vector_type(16)));
typedef float f32x4 __attribute__((ext_vector_type(4)));
typedef unsigned u32x4 __attribute__((ext_vector_type(4)));
constexpr int NW = 8, QBLK = 32, KVBLK = 64, QB = NW * QBLK, DV = 128;
constexpr int SHM_V = KVBLK * DV * 2, SHM_K = KVBLK * 128 * 2;
constexpr int OFF_WS = 2 * SHM_V + 2 * SHM_K, OFF_BIAS = OFF_WS + NW * 64 * 4, LDS_BYTES = OFF_BIAS + 2 * 64 * 4;
constexpr float THR = 8.f;
#define SBAR() __builtin_amdgcn_sched_barrier(0)
template <int DQK> __device__ __forceinline__ int kswz(int row, int colB) { return row * (DQK * 2) + (colB ^ (((DQK == 64 ? (row >> 1) : row) & 7) << 4)); }
__device__ __forceinline__ int v_st(int k, int c) { const int kk = (k & ~0xC) | ((k & 4) << 1) | ((k & 8) >> 1); return ((kk >> 3) * 4 + (c >> 5)) * 512 + ((kk & 7) * 32 + (c & 31)) * 2; }
__device__ __forceinline__ int v_rd_base(int lane) { return ((lane & 3) << 3) | (((lane >> 2) & 3) << 6) | (((lane >> 4) & 1) << 5) | (((lane >> 5) & 1) << 8); }
constexpr int v_rd_off(int d0, int ks, int half) { return d0 * 512 + ks * 4096 + half * 2048; }
template <int CTRL> __device__ __forceinline__ float dppf(float v) { return __int_as_float(__builtin_amdgcn_update_dpp(0, __float_as_int(v), CTRL, 0xf, 0xf, false)); }
__device__ __forceinline__ float row16_sum(float s) { s += dppf<0x128>(s); s += dppf<0x124>(s); s += dppf<0x122>(s); s += dppf<0x121>(s); return s; }
__device__ __forceinline__ float xor1(float v) { return dppf<0xB1>(v); }
__device__ __forceinline__ int crow(int r, int hi) { return (r & 3) + 8 * (r >> 2) + 4 * hi; }
__device__ __forceinline__ unsigned cvtpk(float lo, float hi) { unsigned r; asm volatile("v_cvt_pk_bf16_f32 %0, %1, %2" : "=v"(r) : "v"(lo), "v"(hi)); return r; }
__device__ __forceinline__ void mask_tile(f32x16& p0, f32x16& p1, int dq) {
    const float NEG = -__builtin_inff();
#pragma unroll
    for (int r = 0; r < 16; ++r) {
        const int c = (r & 3) + 8 * (r >> 2);
        if (dq - c < 0) p0[r] = NEG;
        if (dq - c - 32 < 0) p1[r] = NEG;
    }
}
template <int DQK>
__device__ __forceinline__ void partialSM(f32x16& p0, f32x16& p1, float& m_reg, float& mn, float& alpha) {
    constexpr float SCALE = DQK == 128 ? 0.08838834764831845f : 0.125f;
    float pmax = p0[0];
#pragma unroll
    for (int r = 1; r < 16; ++r) pmax = fmaxf(pmax, p0[r]);
#pragma unroll
    for (int r = 0; r < 16; ++r) pmax = fmaxf(pmax, p1[r]);
    { auto rr = __builtin_amdgcn_permlane32_swap(__float_as_uint(pmax), __float_as_uint(pmax), false, false);
      pmax = fmaxf(__uint_as_float(rr[0]), __uint_as_float(rr[1])); }
    constexpr float C2 = 1.4426950408889634f * SCALE;
    if (__builtin_expect(__all((pmax - m_reg) * SCALE <= THR), 1)) { mn = m_reg; alpha = 1.f; }
    else { mn = fmaxf(m_reg, pmax); alpha = __builtin_amdgcn_exp2f((m_reg - mn) * C2); m_reg = mn; }
    const float mnL = -mn * C2;
#pragma unroll
    for (int r = 0; r < 16; ++r) p0[r] = fmaf(p0[r], C2, mnL);
#pragma unroll
    for (int r = 0; r < 16; ++r) p1[r] = fmaf(p1[r], C2, mnL);
#pragma unroll
    for (int r = 0; r < 16; ++r) p0[r] = __builtin_amdgcn_exp2f(p0[r]);
}
__device__ __forceinline__ void finishSM(f32x16& p0, f32x16& p1, float alpha, float& l_reg, bf16x8& pa0, bf16x8& pa1, bf16x8& pa2, bf16x8& pa3) {
#pragma unroll
    for (int r = 0; r < 16; ++r) p1[r] = __builtin_amdgcn_exp2f(p1[r]);
    float ps = 0;
#pragma unroll
    for (int r = 0; r < 16; ++r) ps += p0[r];
#pragma unroll
    for (int r = 0; r < 16; ++r) ps += p1[r];
    { auto rr = __builtin_amdgcn_permlane32_swap(__float_as_uint(ps), __float_as_uint(ps), false, false);
      ps = __uint_as_float(rr[0]) + __uint_as_float(rr[1]); }
    l_reg = l_reg * alpha + ps;
#define PK4(P, B_, OUT) do { unsigned a0 = cvtpk(P[B_+0], P[B_+1]), a1 = cvtpk(P[B_+2], P[B_+3]);                          \
        unsigned b0 = cvtpk(P[B_+4], P[B_+5]), b1 = cvtpk(P[B_+6], P[B_+7]);                                             \
        auto r0 = __builtin_amdgcn_permlane32_swap(a0, b0, false, false); auto r1 = __builtin_amdgcn_permlane32_swap(a1, b1, false, false); \
        u32x4 w = {r0[0], r1[0], r0[1], r1[1]}; OUT = *reinterpret_cast<bf16x8*>(&w); } while (0)
    PK4(p0, 0, pa0); PK4(p0, 8, pa1); PK4(p1, 0, pa2); PK4(p1, 8, pa3);
#undef PK4
}
template <int KB, int DQK, bool BIAS>
__device__ __forceinline__ void qkt(f32x16& p0, f32x16& p1, const char* K_lds, const char* B_lds, int r32, int hi, const bf16x8* qr) {
    if constexpr (BIAS) {
        const f32x4* bp = reinterpret_cast<const f32x4*>(B_lds + KB * 256 + hi * 16);
#pragma unroll
        for (int g = 0; g < 4; ++g) { const f32x4 a = bp[2 * g], b = bp[2 * g + 8];
            p0[4 * g] = a[0]; p0[4 * g + 1] = a[1]; p0[4 * g + 2] = a[2]; p0[4 * g + 3] = a[3];
            p1[4 * g] = b[0]; p1[4 * g + 1] = b[1]; p1[4 * g + 2] = b[2]; p1[4 * g + 3] = b[3]; }
    } else { p0 = f32x16{}; p1 = f32x16{}; }
    constexpr int NK = DQK / 16, NB = NK < 4 ? NK : 4;
    const char* kb[NB];
#pragma unroll
    for (int dd = 0; dd < NB; ++dd) kb[dd] = K_lds + KB * SHM_K + kswz<DQK>(r32, (dd * 16 + hi * 8) * 2);
#pragma unroll
    for (int d0 = 0; d0 < NK; ++d0) { const char* a = kb[d0 & 3] + (d0 >> 2) * 128;
        bf16x8 b0 = *reinterpret_cast<const bf16x8*>(a);
        bf16x8 b1 = *reinterpret_cast<const bf16x8*>(a + 32 * DQK * 2);
        p0 = __builtin_amdgcn_mfma_f32_32x32x16_bf16(b0, qr[d0], p0, 0, 0, 0);
        p1 = __builtin_amdgcn_mfma_f32_32x32x16_bf16(b1, qr[d0], p1, 0, 0, 0); }
}
template <int VB>
__device__ __forceinline__ void pv_tile(f32x16* o, int vb0, bf16x8 pa0, bf16x8 pa1, bf16x8 pa2, bf16x8 pa3) {
#define TRRD(dst, off) asm volatile("ds_read_b64_tr_b16 %0, %1 offset:%2" : "=&v"(dst) : "v"(vb0), "i"(off) : "memory")
#define PV_KS(ks, PA) do { s16x4 l0, l1, l2, l3, h0, h1, h2, h3; constexpr int b_ = VB * SHM_V + v_rd_off(0, ks, 0); \
        TRRD(l0, b_); TRRD(h0, b_ + 2048); TRRD(l1, b_ + 512); TRRD(h1, b_ + 512 + 2048); TRRD(l2, b_ + 1024); TRRD(h2, b_ + 1024 + 2048); TRRD(l3, b_ + 1536); TRRD(h3, b_ + 1536 + 2048); \
        asm volatile("s_waitcnt lgkmcnt(0)" ::: "memory"); SBAR();   \
        o[0] = __builtin_amdgcn_mfma_f32_32x32x16_bf16(PA, (bf16x8){l0[0], l0[1], l0[2], l0[3], h0[0], h0[1], h0[2], h0[3]}, o[0], 0, 0, 0);   \
        o[1] = __builtin_amdgcn_mfma_f32_32x32x16_bf16(PA, (bf16x8){l1[0], l1[1], l1[2], l1[3], h1[0], h1[1], h1[2], h1[3]}, o[1], 0, 0, 0);   \
        o[2] = __builtin_amdgcn_mfma_f32_32x32x16_bf16(PA, (bf16x8){l2[0], l2[1], l2[2], l2[3], h2[0], h2[1], h2[2], h2[3]}, o[2], 0, 0, 0);   \
        o[3] = __builtin_amdgcn_mfma_f32_32x32x16_bf16(PA, (bf16x8){l3[0], l3[1], l3[2], l3[3], h3[0], h3[1], h3[2], h3[3]}, o[3], 0, 0, 0); } while (0)
    PV_KS(0, pa0); PV_KS(1, pa1); PV_KS(2, pa2); PV_KS(3, pa3);
#undef PV_KS
#undef TRRD
}

template <int VB, int DQK>
__device__ __forceinline__ void pv_sm(f32x16* o, int vb0, bf16x8 pa0, bf16x8 pa1, bf16x8 pa2, bf16x8 pa3, f32x16& p0, f32x16& p1, float& m_reg, float& mn, float& alpha) {
    constexpr float SCALE = DQK == 128 ? 0.08838834764831845f : 0.125f;
    constexpr float C2 = 1.4426950408889634f * SCALE;
#define TRRD(dst, off) asm volatile("ds_read_b64_tr_b16 %0, %1 offset:%2" : "=&v"(dst) : "v"(vb0), "i"(off) : "memory")
#define PV_LD(ks, S) do { constexpr int b_ = VB * SHM_V + v_rd_off(0, ks, 0); \
        TRRD(S##l0, b_); TRRD(S##h0, b_ + 2048); TRRD(S##l1, b_ + 512); TRRD(S##h1, b_ + 512 + 2048); TRRD(S##l2, b_ + 1024); TRRD(S##h2, b_ + 1024 + 2048); TRRD(S##l3, b_ + 1536); TRRD(S##h3, b_ + 1536 + 2048); } while (0)
#define PV_WAIT() do { asm volatile("s_waitcnt lgkmcnt(0)" ::: "memory"); SBAR(); } while (0)
#define MM(ks, S, j, PA) do { o[j] = __builtin_amdgcn_mfma_f32_32x32x16_bf16(PA, (bf16x8){S##l##j[0], S##l##j[1], S##l##j[2], S##l##j[3], S##h##j[0], S##h##j[1], S##h##j[2], S##h##j[3]}, o[j], 0, 0, 0); SBAR(); } while (0)
#define VMX(P, i) do { pm = fmaxf(fmaxf(pm, P[i]), P[(i) + 1]); pm = fmaxf(fmaxf(pm, P[(i) + 2]), P[(i) + 3]); SBAR(); } while (0)
#define VFE(k) do { float a_ = __builtin_amdgcn_exp2f(fmaf(p0[2 * (k)], C2, mnL)), b_ = __builtin_amdgcn_exp2f(fmaf(p0[2 * (k) + 1], C2, mnL)), c_ = fmaf(p1[2 * (k)], C2, mnL), d_ = fmaf(p1[2 * (k) + 1], C2, mnL); \
        asm volatile("" : "+v"(a_), "+v"(b_), "+v"(c_), "+v"(d_));     \
        p0[2 * (k)] = a_; p0[2 * (k) + 1] = b_; p1[2 * (k)] = c_; p1[2 * (k) + 1] = d_; SBAR(); } while (0)
    s16x4 Al0, Al1, Al2, Al3, Ah0, Ah1, Ah2, Ah3, Bl0, Bl1, Bl2, Bl3, Bh0, Bh1, Bh2, Bh3;
    PV_LD(0, A); PV_WAIT(); PV_LD(1, B);
    float pm = fmaxf(p0[0], p0[1]);
    MM(0, A, 0, pa0); pm = fmaxf(fmaxf(pm, p0[2]), p0[3]); SBAR();
    MM(0, A, 1, pa0); VMX(p0, 4);
    MM(0, A, 2, pa0); VMX(p0, 8);
    MM(0, A, 3, pa0); VMX(p0, 12);
    PV_WAIT(); PV_LD(2, A);
    MM(1, B, 0, pa1); VMX(p1, 0);
    MM(1, B, 1, pa1); VMX(p1, 4);
    MM(1, B, 2, pa1); VMX(p1, 8);
    MM(1, B, 3, pa1); VMX(p1, 12);
    { auto rr = __builtin_amdgcn_permlane32_swap(__float_as_uint(pm), __float_as_uint(pm), false, false);
      pm = fmaxf(__uint_as_float(rr[0]), __uint_as_float(rr[1])); }
    const bool keep = __all((pm - m_reg) * SCALE <= THR);
    mn = keep ? m_reg : fmaxf(m_reg, pm);
    alpha = __builtin_amdgcn_exp2f((m_reg - mn) * C2);
    m_reg = mn;
    const float mnL = -mn * C2;
    SBAR();
    PV_WAIT(); PV_LD(3, B);
    MM(2, A, 0, pa2); VFE(0);
    MM(2, A, 1, pa2); VFE(1);
    MM(2, A, 2, pa2); VFE(2);
    MM(2, A, 3, pa2); VFE(3);
    PV_WAIT();
    MM(3, B, 0, pa3); VFE(4);
    MM(3, B, 1, pa3); VFE(5);
    MM(3, B, 2, pa3); VFE(6);
    MM(3, B, 3, pa3); VFE(7);
#undef VFE
#undef VMX
#undef MM
#undef PV_WAIT
#undef PV_LD
#undef TRRD
}

__device__ __forceinline__ int fox_jlo(const float* Fb, int P0, float thr, int lane) {
    const int ntile = P0 >> 6;
    const float fe = Fb[64 * (lane < ntile ? lane : 0) + 63], f0 = Fb[P0];
    const bool skip = (lane < ntile) && ((f0 - fe) > thr);
    const unsigned long long mk = __ballot(skip);
    return __builtin_amdgcn_readfirstlane((int)__builtin_ctzll(~mk));
}
template <class TOut> struct BlockRef { const bf16* Q; const bf16* K; const bf16* V; const float* Fb; TOut* O; bf16* MX; int P0; int comp; };
template <int DQK> struct Seam { bf16x8 qr[DQK / 16]; bf16x8 st_v0, st_v1, st_k0, st_k1; float st_b; };

#define VMW() asm volatile("s_waitcnt vmcnt(0)" ::: "memory")
#define VMWN(n) asm volatile("s_waitcnt vmcnt(%0)" :: "i"(n) : "memory")
#define A_SLOAD(Kp, Vp, Fp, k0) do { const char* vb_ = (const char*)(Vp) + (size_t)(k0) * (DV * 2); const char* kb_ = (const char*)(Kp) + (size_t)(k0) * (DQK * 2); \
        S.st_v0 = *(const bf16x8*)(vb_ + voff); S.st_v1 = *(const bf16x8*)(vb_ + 32 * DV * 2 + voff); \
        if constexpr (DQK == 128) { S.st_k0 = *(const bf16x8*)(kb_ + voff); S.st_k1 = *(const bf16x8*)(kb_ + 32 * 256 + voff); } \
        else { S.st_k0 = *(const bf16x8*)(kb_ + koff64); } \
        if constexpr (BIAS) { S.st_b = *(const float*)((const char*)((Fp) + (k0)) + boff); } } while (0)
#define A_SWRITE_K(bf) do { if constexpr (DQK == 128) { *(bf16x8*)(K_lds + (bf) * SHM_K + kws) = S.st_k0; *(bf16x8*)(K_lds + (bf) * SHM_K + kws + 32 * 256) = S.st_k1; } \
        else { *(bf16x8*)(K_lds + (bf) * SHM_K + kws) = S.st_k0; } \
        if constexpr (BIAS) { if (wid == 0) *(float*)(B_lds + (bf) * 256 + lane * 4) = S.st_b; } } while (0)
#define A_SWRITE_V(bf) do { *(bf16x8*)(V_lds + (bf) * SHM_V + vst0) = S.st_v0; *(bf16x8*)(V_lds + (bf) * SHM_V + vst1) = S.st_v1; } while (0)
#define A_SWRITE(bf) do { A_SWRITE_V(bf); A_SWRITE_K(bf); } while (0)
#define A_GEOM() const int tid = ltid(), wid = __builtin_amdgcn_readfirstlane(tid >> 6), lane = tid & 63, r32 = lane & 31, hi = lane >> 5; \
    const int sr = tid >> 4, sc = (tid & 15) * 8, kr64 = tid >> 3, kc64 = (tid & 7) * 8; \
    const int kws = DQK == 128 ? kswz<128>(sr, sc * 2) : kswz<64>(kr64, kc64 * 2); \
    const unsigned voff = (unsigned)(sr * DV + sc) * 2u, koff64 = (unsigned)(kr64 * 64 + kc64) * 2u, boff = (unsigned)lane * 4u; (void)voff; (void)koff64; (void)boff; \
    char* V_lds = lds; char* K_lds = lds + 2 * SHM_V; char* B_lds = lds + OFF_BIAS; (void)V_lds; (void)B_lds; (void)r32; (void)hi; (void)kr64; (void)kc64; (void)sr; (void)sc

template <int DQK, bool BIAS, class TOut>
__device__ __forceinline__ void causal_prime(const BlockRef<TOut>& cur, int jlo, char* lds, Seam<DQK>& S) {
    A_GEOM();
#pragma unroll
    for (int d0 = 0; d0 < DQK / 16; ++d0) S.qr[d0] = *(const bf16x8*)(cur.Q + (size_t)(wid * QBLK + r32) * DQK + d0 * 16 + hi * 8);
    A_SLOAD(cur.K, cur.V, cur.Fb, jlo * KVBLK); VMW(); A_SWRITE_K(0);
    __syncthreads();
}
template <int DQK, bool BIAS, class TOut, int OST, class RF>
__device__ __forceinline__ void causal_block(const RF& rf, int Lc, int pc, int Ln, int pn, char* lds, Seam<DQK>& S) {
    A_GEOM();
    const BlockRef<TOut> cur = rf(Lc, pc);
    int jlo = 0; if constexpr (BIAS) jlo = rf.jlo_of(pc);
    const int NT = (cur.P0 + QB - 1) / KVBLK + 1 - jlo;
    const int qlo = cur.P0 + wid * QBLK, qm = qlo + r32 - 4 * hi;
    float* ws = (float*)(lds + OFF_WS) + wid * 64; float* li_l = ws, * al_l = ws + 32;
    float m_reg = -1e30f, l_reg = 0; f32x16 o[4] = {};
    const int vst0 = v_st(sr, sc), vst1 = v_st(32 + sr, sc);
    const int vb0 = (int)(uintptr_t)V_lds + v_rd_base(lane);
    const bf16* Kh = cur.K; const bf16* Vh = cur.V; const float* Fh = cur.Fb;
#define RESC(a) do { if (__any((a) < 1.f)) { if (hi == 0) al_l[r32] = (a); asm volatile("s_waitcnt lgkmcnt(0)" ::: "memory");              \
                     for (int d_ = 0; d_ < 4; ++d_) for (int r = 0; r < 16; ++r) o[d_][r] *= al_l[crow(r, hi)]; } } while (0)
#define KBASE(t) ((jlo + (t)) * KVBLK)
#define MASKT(P0_, P1_, t) do { const int kb_ = KBASE(t); if (kb_ + KVBLK - 1 > qlo) mask_tile(P0_, P1_, qm - kb_); } while (0)
    constexpr int NQL = DQK / 16;
    f32x16 pA0, pA1, pB0, pB1; float mnA, mnB, alA, alB; bf16x8 pa0, pa1, pa2, pa3;
    A_SWRITE_V(0); SBAR();
    if (NT > 1) { A_SLOAD(Kh, Vh, Fh, KBASE(1)); }
    SBAR(); qkt<0, DQK, BIAS>(pA0, pA1, K_lds, B_lds, r32, hi, S.qr);
    MASKT(pA0, pA1, 0); partialSM<DQK>(pA0, pA1, m_reg, mnA, alA);
    if (NT > 1) { VMW(); A_SWRITE(1); }
    __syncthreads();
#define HALF_STEP(PX0, PX1, mnX, alX, PY0, PY1, alY, t, KB, VB, SB) do {                                                      \
        SBAR(); qkt<KB, DQK, BIAS>(PX0, PX1, K_lds, B_lds, r32, hi, S.qr);                                                    \
        finishSM(PY0, PY1, alY, l_reg, pa0, pa1, pa2, pa3); SBAR();                                                           \
        if ((t) + 1 < NT) { A_SLOAD(Kh, Vh, Fh, KBASE((t) + 1)); SBAR(); }                                                    \
        if constexpr (BIAS) { pv_tile<VB>(o, vb0, pa0, pa1, pa2, pa3); MASKT(PX0, PX1, (t)); partialSM<DQK>(PX0, PX1, m_reg, mnX, alX); } \
        else { MASKT(PX0, PX1, (t)); SBAR(); pv_sm<VB, DQK>(o, vb0, pa0, pa1, pa2, pa3, PX0, PX1, m_reg, mnX, alX); }         \
        __syncthreads();                                                                                                      \
        if ((t) + 1 < NT) { VMW(); A_SWRITE(SB); }                                                                            \
        RESC(alX); __syncthreads(); } while (0)
    for (int t = 1; t + 1 < NT; t += 2) {
        HALF_STEP(pB0, pB1, mnB, alB, pA0, pA1, alA, t, 1, 0, 0);
        HALF_STEP(pA0, pA1, mnA, alA, pB0, pB1, alB, t + 1, 0, 1, 1);
    }
    const bool even = (NT & 1) == 0;
    if (even) { SBAR(); qkt<1, DQK, BIAS>(pB0, pB1, K_lds, B_lds, r32, hi, S.qr); SBAR(); }
    { const BlockRef<TOut> nxt = rf(Ln, pn);
    int jn = 0; if constexpr (BIAS) jn = rf.jlo_of(pn);
    A_SLOAD(nxt.K, nxt.V, nxt.Fb, jn * KVBLK); SBAR();
#pragma unroll
    for (int d0 = 0; d0 < DQK / 16; ++d0) S.qr[d0] = *(const bf16x8*)(nxt.Q + (size_t)(wid * QBLK + r32) * DQK + d0 * 16 + hi * 8);
    }
    SBAR();
    finishSM(pA0, pA1, alA, l_reg, pa0, pa1, pa2, pa3); SBAR();
    pv_tile<0>(o, vb0, pa0, pa1, pa2, pa3);
    if (even) { MASKT(pB0, pB1, NT - 1); partialSM<DQK>(pB0, pB1, m_reg, mnB, alB); __syncthreads(); RESC(alB);
        finishSM(pB0, pB1, alB, l_reg, pa0, pa1, pa2, pa3); SBAR(); pv_tile<1>(o, vb0, pa0, pa1, pa2, pa3); }
    SBAR(); VMWN(NQL); A_SWRITE_K(0); SBAR();
    if (hi == 0) li_l[r32] = l_reg; asm volatile("s_waitcnt lgkmcnt(0)" ::: "memory");
    float rli[16];
#pragma unroll
    for (int r = 0; r < 16; ++r) rli[r] = __builtin_amdgcn_rcpf(li_l[crow(r, hi)]);
    { const BlockRef<TOut> ce = rf(Lc, pc);
    TOut* Ow = ce.O + (size_t)(wid * QBLK) * OST;
    if constexpr (sizeof(TOut) == 4) {
        if (ce.comp == 0) {
#pragma unroll
            for (int r = 0; r < 16; ++r) { const int orow = crow(r, hi);
#pragma unroll
                for (int d0 = 0; d0 < 4; ++d0) Ow[(size_t)orow * OST + d0 * 32 + r32] = o[d0][r] * rli[r]; }
        } else {
            bf16* Mw = ce.MX + (size_t)(wid * QBLK) * 2048;
            float gs[4];
#pragma unroll
            for (int d0 = 0; d0 < 4; ++d0) gs[d0] = rf.gsub[d0 * 32 + r32] * rf.gmul;
            const float lam = rf.lam;
            f32x16 o1[4];
#pragma unroll
            for (int r = 0; r < 16; ++r) { const int orow = crow(r, hi);
#pragma unroll
                for (int d0 = 0; d0 < 4; ++d0) o1[d0][r] = Ow[(size_t)orow * OST + d0 * 32 + r32]; }
            SBAR();
#pragma unroll
            for (int r = 0; r < 16; ++r) { const int orow = crow(r, hi); float e[4], ss = 0.f;
#pragma unroll
                for (int d0 = 0; d0 < 4; ++d0) { e[d0] = o1[d0][r] - lam * (o[d0][r] * rli[r]); ss += e[d0] * e[d0]; }
                ss = row16_sum(ss); { auto rr = __builtin_amdgcn_permlane16_swap(__float_as_uint(ss), __float_as_uint(ss), false, false); ss = __uint_as_float(rr[0]) + __uint_as_float(rr[1]); }
                const float rinv = 1.f / sqrtf(ss * (1.f / 128.f) + 1e-5f);
#pragma unroll
                for (int d0 = 0; d0 < 4; ++d0) { const float v = e[d0] * rinv * gs[d0]; const float vn = xor1(v);
                    if ((r32 & 1) == 0) *(unsigned*)(Mw + (size_t)orow * 2048 + d0 * 32 + r32) = cvtpk(v, vn); } }
        }
    } else {
#pragma unroll
        for (int r = 0; r < 16; ++r) { const int orow = crow(r, hi);
#pragma unroll
            for (int d0 = 0; d0 < 4; ++d0) { const float v = o[d0][r] * rli[r]; const float vn = xor1(v);
                if ((r32 & 1) == 0) *(unsigned*)(Ow + (size_t)orow * OST + d0 * 32 + r32) = cvtpk(v, vn); } }
    } }
    __syncthreads();
#undef RESC
#undef KBASE
#undef MASKT
#undef HALF_STEP
}
#undef VMW
#undef VMWN
#undef A_SLOAD
#undef A_SWRITE_K
#undef A_SWRITE_V
#undef A_SWRITE
#undef A_GEOM
}
#define LAS __attribute__((address_space(3)))
#define XB_TMO      128
#define XB_XCNT(j)  (256  + 64 * (j))
#define XB_XSUB(j)  (1280 + 64 * (j))
#define XB_XGEN(j)  (2304 + 64 * (j))
#define XB_TOP      3328
#define XB_TOPGEN   3392
#define XCD_BAR_WORDS 3456
#define XB_SPIN_CAP (1u << 18)

__device__ __forceinline__ unsigned xb_ld(unsigned* p)              { return __hip_atomic_load(p, __ATOMIC_RELAXED, __HIP_MEMORY_SCOPE_AGENT); }
__device__ __forceinline__ unsigned xb_add(unsigned* p, unsigned v) { return __hip_atomic_fetch_add(p, v, __ATOMIC_RELAXED, __HIP_MEMORY_SCOPE_AGENT); }
__device__ __forceinline__ unsigned xb_xcc_id() { return (unsigned)__builtin_amdgcn_s_getreg((3 << 11) | 20) & 0xFu; }
#define XB_SPIN(cond, bar) do { unsigned _sp = 0; while (cond) { __builtin_amdgcn_s_sleep(1); \
    if ((++_sp & 255u) == 0u) { if (xb_ld(&(bar)[XB_TMO])) break; if (_sp > XB_SPIN_CAP) { atomicAdd(&(bar)[XB_TMO], 1u); break; } } } } while (0)

struct XcdBarrier {
    unsigned* bar; unsigned x;
    volatile LAS unsigned* st;
};

__device__ __forceinline__ XcdBarrier xcd_barrier_post(unsigned* bar, volatile LAS unsigned* st) {
    XcdBarrier b; b.bar = bar; b.x = xb_xcc_id(); b.st = st;
    if (threadIdx.x == 0) (void)xb_add(&bar[XB_XCNT(b.x)], 1u);
    return b;
}
__device__ __forceinline__ void xcd_barrier_complete(unsigned* bar, unsigned x, unsigned& nloc, unsigned& nx) {
    const unsigned G = gridDim.x * gridDim.y * gridDim.z;
    unsigned sum, cnt, mine, sp = 0u;
    for (;;) {
        sum = 0u; cnt = 0u; mine = 0u;
#pragma unroll
        for (unsigned j = 0; j < 16; ++j) { const unsigned c = xb_ld(&bar[XB_XCNT(j)]); sum += c; cnt += (c > 0u) ? 1u : 0u; mine = (j == x) ? c : mine; }
        if (sum == G) break;
        __builtin_amdgcn_s_sleep(1);
        if ((++sp & 255u) == 0u) { if (xb_ld(&bar[XB_TMO])) break; if (sp > XB_SPIN_CAP) { atomicAdd(&bar[XB_TMO], 1u); break; } }
    }
    nloc = mine > 0u ? mine : 1u; nx = cnt > 0u ? cnt : 1u;
}

__device__ __forceinline__ void xcd_barrier(const XcdBarrier& b) {
    asm volatile("s_waitcnt vmcnt(0)" ::: "memory");
    __syncthreads();
    if (threadIdx.x == 0) {
        unsigned* bar = b.bar;
        __builtin_amdgcn_s_waitcnt(0);
        unsigned nloc = b.st[0], nx = b.st[1];
        if (nloc == 0u) { xcd_barrier_complete(bar, b.x, nloc, nx); b.st[0] = nloc; b.st[1] = nx; }
        const unsigned old = xb_add(&bar[XB_XSUB(b.x)], 1u);
        const unsigned gen = old / nloc;
        if (old + 1u == (gen + 1u) * nloc) {
            __builtin_amdgcn_fence(__ATOMIC_RELEASE, "agent");
            asm volatile("s_waitcnt vmcnt(0)" ::: "memory");
            const unsigned og = xb_add(&bar[XB_TOP], 1u);
            const unsigned tg = og / nx;
            if (og + 1u == (tg + 1u) * nx) xb_add(&bar[XB_TOPGEN], 1u);
            else XB_SPIN(xb_ld(&bar[XB_TOPGEN]) == tg, bar);
            __builtin_amdgcn_fence(__ATOMIC_ACQUIRE, "agent");
            xb_add(&bar[XB_XGEN(b.x)], 1u);
            asm volatile("s_waitcnt vmcnt(0)" ::: "memory");
        } else {
            XB_SPIN(xb_ld(&bar[XB_XGEN(b.x)]) == gen, bar);
            __builtin_amdgcn_fence(__ATOMIC_ACQUIRE, "agent");
            asm volatile("s_waitcnt vmcnt(0)" ::: "memory");
        }
    }
    __syncthreads();
}

constexpr int BATCH = 4, SEQ = 4096, DM = 2048, DEPTH = 2, NFOX = 8, NDIFF = 8, HD = 128, DFF = 8192, INCOLS = 6152, NQKV = 6144;
constexpr int M = BATCH * SEQ;
constexpr float LN_EPS = 1e-5f, RMS_EPS = 1e-5f, ALPHA = 1.4142135623730951f;
constexpr float FOX_INV_SCALE = 11.313708498984761f;
constexpr int NWAVES = 8, NTHREADS = 512;
constexpr int LDS_BYTES = 147456;

constexpr size_t MiB = 1u << 20;
constexpr size_t WS_MOD = 0;
constexpr size_t WS_BAR = 512 * 1024;
constexpr size_t WS_ROPE = 1 * MiB;
constexpr size_t WS_LF = 2 * MiB;
constexpr size_t WS_FB = 3 * MiB;
constexpr size_t WS_WIN = 4 * MiB;
constexpr size_t WS_WO = 28 * MiB;
constexpr size_t WS_WUP = 36 * MiB;
constexpr size_t WS_WDN = 68 * MiB;
constexpr size_t WS_H = 100 * MiB;
constexpr size_t WS_QKV = 164 * MiB;
constexpr size_t WS_MIX = 356 * MiB;
constexpr size_t WS_U = 164 * MiB;
constexpr size_t WS_Z = 420 * MiB;
constexpr size_t WS_OD = 420 * MiB;
constexpr size_t WS_XA = 548 * MiB;
constexpr size_t WS_X2 = 612 * MiB;
constexpr size_t WS_END = 676 * MiB;

typedef unsigned short bf16;
typedef float f32x4 __attribute__((ext_vector_type(4)));
typedef unsigned u32x4 __attribute__((ext_vector_type(4)));
typedef unsigned u32x2 __attribute__((ext_vector_type(2)));
#ifndef LAS
#define LAS __attribute__((address_space(3)))
#endif

#include <type_traits>
struct Params {
    const float* x; const float* c; const int* pos; const float* w_ada; const float* b_ada; const float* w_in; const float* b_f;
    const float* lq1; const float* lk1; const float* lq2; const float* lk2; const float* subln_g; const float* w_o;
    const float* ln1_g; const float* ln1_b; const float* w_up; const float* w_down; const float* ln2_g; const float* ln2_b;
    float* out; unsigned char* ws;
};

__device__ __forceinline__ unsigned f2bf(float f) { unsigned u = __builtin_bit_cast(unsigned, f); return (u + 0x7fffu + ((u >> 16) & 1u)) >> 16; }
__device__ __forceinline__ unsigned pk2(float lo, float hi) { return f2bf(lo) | (f2bf(hi) << 16); }
__device__ __forceinline__ float wave_sum(float v) {
#pragma unroll
    for (int o = 1; o < 64; o <<= 1) v += __shfl_xor(v, o);
    return v;
}
#define LDS_WAIT() asm volatile("s_waitcnt lgkmcnt(0)" ::: "memory")

struct TrItem { const float* W; bf16* WT; int K, N, ldw, col_off, row_off, item; };
__device__ __forceinline__ void tr_load(const TrItem& t, float (&tv)[32], int lane) {
    const int nblk = t.N / 32, kb = t.item / nblk, nb = t.item % nblk, k0 = 64 * kb, n0 = 32 * nb;
#pragma unroll
    for (int i = 0; i < 32; ++i) { const int kk = 2 * i + (lane >> 5); tv[i] = t.W[(size_t)(k0 + kk) * t.ldw + t.col_off + n0 + (lane & 31)]; }
    __builtin_amdgcn_sched_barrier(0);
}
__device__ __forceinline__ void tr_store(const TrItem& t, const float (&tv)[32], LAS float* scr, int lane) {
    const int nblk = t.N / 32, kb = t.item / nblk, nb = t.item % nblk, k0 = 64 * kb, n0 = 32 * nb;
#pragma unroll
    for (int i = 0; i < 32; ++i) { const int kk = 2 * i + (lane >> 5); scr[kk * 33 + (lane & 31)] = tv[i]; }
    LDS_WAIT(); asm volatile("" ::: "memory");
    const int c = lane & 7;
#pragma unroll
    for (int j = 0; j < 4; ++j) { const int n = (lane >> 3) + 8 * j; const LAS float* s = scr + (8 * c) * 33 + n;
        u32x4 o; o.x = pk2(s[0 * 33], s[1 * 33]); o.y = pk2(s[2 * 33], s[3 * 33]); o.z = pk2(s[4 * 33], s[5 * 33]); o.w = pk2(s[6 * 33], s[7 * 33]);
        *(u32x4*)(t.WT + (size_t)(t.row_off + n0 + n) * t.K + k0 + 8 * c) = o; }
    LDS_WAIT(); asm volatile("" ::: "memory");
}
__device__ __forceinline__ void convert_weights(const Params& P, int l, LAS unsigned char* lds, int gw, int NGW, int wave, int lane) {
    LAS float* scr = (LAS float*)(lds + wave * 16384);
    unsigned char* ws = P.ws;
    constexpr int I_IN = (DM / 64) * (3072 / 32), I_O = (DM / 64) * (DM / 32), I_UP = (DM / 64) * (DFF / 32), I_DN = (DFF / 64) * (DM / 32);
    constexpr int NITEMS = 2 * I_IN + I_O + I_UP + I_DN;
    const float* w_in = P.w_in + (size_t)l * DM * INCOLS; const float* w_o = P.w_o + (size_t)l * DM * DM;
    const float* w_up = P.w_up + (size_t)l * DM * DFF; const float* w_dn = P.w_down + (size_t)l * DFF * DM;
#define TR_ITEM(t_, it_) do { int r = (it_); \
        if (r < I_IN) { t_ = TrItem{w_in, (bf16*)(ws + WS_WIN), DM, 3072, INCOLS, 0, 0, r}; } \
        else if ((r -= I_IN) < I_IN) { t_ = TrItem{w_in, (bf16*)(ws + WS_WIN), DM, 3072, INCOLS, 3080, 3072, r}; } \
        else if ((r -= I_IN) < I_O) { t_ = TrItem{w_o, (bf16*)(ws + WS_WO), DM, DM, DM, 0, 0, r}; } \
        else if ((r -= I_O) < I_UP) { t_ = TrItem{w_up, (bf16*)(ws + WS_WUP), DM, DFF, DFF, 0, 0, r}; } \
        else { r -= I_UP; t_ = TrItem{w_dn, (bf16*)(ws + WS_WDN), DFF, DM, DM, 0, 0, r}; } } while (0)
    float ta[32], tb[32]; TrItem A, B;
    int it = gw;
    if (it < NITEMS) { TR_ITEM(A, it); tr_load(A, ta, lane); }
#pragma unroll 1
    for (; it < NITEMS; it += 2 * NGW) {
        const bool hb = it + NGW < NITEMS;
        if (hb) { TR_ITEM(B, it + NGW); tr_load(B, tb, lane); }
        tr_store(A, ta, scr, lane);
        if (!hb) break;
        if (it + 2 * NGW < NITEMS) { TR_ITEM(A, it + 2 * NGW); tr_load(A, ta, lane); }
        tr_store(B, tb, scr, lane);
    }
#undef TR_ITEM
}
__device__ __forceinline__ void adaln_phase(const Params& P, LAS unsigned char* lds, int tid) {
    LAS float* ca = (LAS float*)lds;
    LAS float* red = (LAS float*)(lds + 32768);
    for (int i = tid; i < BATCH * DM; i += NTHREADS) { const float v = P.c[i]; ca[i] = v / (1.f + __expf(-v)); }
    __syncthreads();
    float* mod = (float*)(P.ws + WS_MOD);
    const int kg = tid >> 5, col = tid & 31;
    constexpr int NCH = 6 * DM / 32;
    for (int it = blockIdx.x; it < DEPTH * NCH; it += gridDim.x) {
        const int l = it / NCH, n0 = (it % NCH) * 32;
        const float* w = P.w_ada + (size_t)l * DM * 6 * DM + n0 + col;
        float a0 = 0.f, a1 = 0.f, a2 = 0.f, a3 = 0.f;
        float wa[16], wb[16];
#define ADA_LD(W_, kb_) do { _Pragma("unroll") for (int i = 0; i < 16; ++i) W_[i] = w[(size_t)((kb_) + kg + 16 * i) * (6 * DM)]; __builtin_amdgcn_sched_barrier(0); } while (0)
#define ADA_FM(W_, kb_) do { _Pragma("unroll") for (int i = 0; i < 16; ++i) { const int k = (kb_) + kg + 16 * i; a0 += ca[k] * W_[i]; a1 += ca[DM + k] * W_[i]; a2 += ca[2 * DM + k] * W_[i]; a3 += ca[3 * DM + k] * W_[i]; } } while (0)
        ADA_LD(wa, 0);
#pragma unroll 1
        for (int kb = 0; kb < DM; kb += 2 * 256) {
            ADA_LD(wb, kb + 256);
            ADA_FM(wa, kb);
            if (kb + 512 < DM) ADA_LD(wa, kb + 512);
            ADA_FM(wb, kb + 256);
        }
#undef ADA_LD
#undef ADA_FM
        red[(kg * 4 + 0) * 32 + col] = a0; red[(kg * 4 + 1) * 32 + col] = a1; red[(kg * 4 + 2) * 32 + col] = a2; red[(kg * 4 + 3) * 32 + col] = a3;
        __syncthreads();
        if (tid < 128) { const int b = tid >> 5; float s = 0.f;
#pragma unroll
            for (int g = 0; g < 16; ++g) s += red[(g * 4 + b) * 32 + col];
            mod[((size_t)l * BATCH + b) * (6 * DM) + n0 + col] = s + P.b_ada[(size_t)l * 6 * DM + n0 + col]; }
        __syncthreads();
    }
}
__device__ __forceinline__ void rope_one(float* rope, int m, int i, float posf, float inv_freq) {
    const float ang = posf * inv_freq;
    const double a = (double)ang, q = __builtin_rint(a * 0.63661977236758134308);
    const double r = (a - q * 1.5707963267948966192) - q * 6.123233995736766e-17, r2 = r * r;
    const double sn = r * (1.0 + r2 * (-1.0 / 6 + r2 * (1.0 / 120 + r2 * (-1.0 / 5040 + r2 * (1.0 / 362880 + r2 * (-1.0 / 39916800 + r2 * (1.0 / 6227020800.0)))))));
    const double cs = 1.0 + r2 * (-0.5 + r2 * (1.0 / 24 + r2 * (-1.0 / 720 + r2 * (1.0 / 40320 + r2 * (-1.0 / 3628800 + r2 * (1.0 / 479001600 + r2 * (-1.0 / 87178291200.0)))))));
    const int qi = ((int)q) & 3;
    const double c = (qi == 0) ? cs : (qi == 1) ? -sn : (qi == 2) ? -cs : sn;
    const double s = (qi == 0) ? sn : (qi == 1) ? cs : (qi == 2) ? -sn : -cs;
    rope[(size_t)m * 16 + i] = (float)c; rope[(size_t)m * 16 + 8 + i] = (float)s;
}
__device__ __forceinline__ void rope_phase(const Params& P, int gtid, int gthreads) {
    float* rope = (float*)(P.ws + WS_ROPE);
    for (int m = gtid; m < M; m += gthreads) {
        const float pf = (float)P.pos[m];
        rope_one(rope, m, 0, pf, 0x1.0000000000000p+0f); rope_one(rope, m, 1, pf, 0x1.8d275e0000000p-3f); rope_one(rope, m, 2, pf, 0x1.3411900000000p-5f); rope_one(rope, m, 3, pf, 0x1.ddee9c0000000p-8f);
        rope_one(rope, m, 4, pf, 0x1.72ba440000000p-10f); rope_one(rope, m, 5, pf, 0x1.1f91f00000000p-12f); rope_one(rope, m, 6, pf, 0x1.be21880000000p-15f); rope_one(rope, m, 7, pf, 0x1.5a0f4e0000000p-17f);
    }
}
__device__ __forceinline__ float log_sigmoid(float x) { return fminf(x, 0.f) - 0.6931471805599453f * __builtin_amdgcn_logf(1.f + __builtin_amdgcn_exp2f(-1.4426950408889634f * fabsf(x))); }

__device__ __forceinline__ void stage_wf(const Params& P, int l, LAS unsigned char* lds, int tid) {
    LAS float* wf = (LAS float*)lds;
    const float* w = P.w_in + (size_t)l * DM * INCOLS + 3072;
    f32x4 a[4], b[4];
#pragma unroll
    for (int i = 0; i < 4; ++i) { const float* p = w + (size_t)(tid + NTHREADS * i) * INCOLS; a[i] = *(const f32x4*)p; b[i] = *(const f32x4*)(p + 4); }
#pragma unroll
    for (int i = 0; i < 4; ++i) { const int k = tid + NTHREADS * i;
        wf[0 * DM + k] = a[i].x; wf[1 * DM + k] = a[i].y; wf[2 * DM + k] = a[i].z; wf[3 * DM + k] = a[i].w;
        wf[4 * DM + k] = b[i].x; wf[5 * DM + k] = b[i].y; wf[6 * DM + k] = b[i].z; wf[7 * DM + k] = b[i].w; }
    __syncthreads();
}
__device__ __forceinline__ unsigned cvtpk_bf16(float lo, float hi) { unsigned r; asm volatile("v_cvt_pk_bf16_f32 %0, %1, %2" : "=v"(r) : "v"(lo), "v"(hi)); return r; }
__device__ __forceinline__ int wave_row(int gw, int NGW, int i) {
    const int wpb = NGW / BATCH;
    if (NGW % BATCH == 0 && SEQ % wpb == 0) return (gw / wpb) * SEQ + (gw % wpb) + i * wpb;
    return gw + i * NGW;
}
__device__ __forceinline__ int wave_nrows(int gw, int NGW) {
    const int wpb = NGW / BATCH;
    if (NGW % BATCH == 0 && SEQ % wpb == 0) return SEQ / wpb;
    return (M - gw + NGW - 1) / NGW;
}
template <bool GATES>
__device__ __forceinline__ void modulate_row(const Params& P, int l, int m, const f32x4 (&xv)[8], const f32x4 (&sc1)[8], const f32x4 (&sh)[8], LAS unsigned char* lds, int lane, float bfl) {
    bf16* hrow = (bf16*)(P.ws + WS_H) + (size_t)m * DM;
    float g0 = 0.f, g1 = 0.f, g2 = 0.f, g3 = 0.f, g4 = 0.f, g5 = 0.f, g6 = 0.f, g7 = 0.f;
#pragma unroll
    for (int j = 0; j < 8; ++j) {
        const int o = 256 * j + 4 * lane;
        const f32x4 h = xv[j] * sc1[j] + sh[j];
        u32x2 ov; ov.x = cvtpk_bf16(h.x, h.y); ov.y = cvtpk_bf16(h.z, h.w);
        *(u32x2*)(hrow + o) = ov;
        if constexpr (GATES) {
            const LAS float* wf = (const LAS float*)lds + o;
#define GDOT(q, acc) { const f32x4 w = *(const LAS f32x4*)(wf + (q) * DM); acc += h.x * w.x + h.y * w.y + h.z * w.z + h.w * w.w; }
            GDOT(0, g0) GDOT(1, g1) GDOT(2, g2) GDOT(3, g3) GDOT(4, g4) GDOT(5, g5) GDOT(6, g6) GDOT(7, g7)
#undef GDOT
            __builtin_amdgcn_sched_barrier(0);
        }
    }
    if constexpr (GATES) {
        const int b = m >> 12, s = m & (SEQ - 1);
        float* lf = (float*)(P.ws + WS_LF);
        { const bool up = lane & 1; const float s0 = up ? g0 : g1, s1 = up ? g2 : g3, s2 = up ? g4 : g5, s3 = up ? g6 : g7;
          const float k0 = up ? g1 : g0, k1 = up ? g3 : g2, k2 = up ? g5 : g4, k3 = up ? g7 : g6;
          g0 = k0 + __shfl_xor(s0, 1); g1 = k1 + __shfl_xor(s1, 1); g2 = k2 + __shfl_xor(s2, 1); g3 = k3 + __shfl_xor(s3, 1); }
        { const bool up = lane & 2; const float s0 = up ? g0 : g1, s1 = up ? g2 : g3; const float k0 = up ? g1 : g0, k1 = up ? g3 : g2;
          g0 = k0 + __shfl_xor(s0, 2); g1 = k1 + __shfl_xor(s1, 2); }
        { const bool up = lane & 4; const float s0 = up ? g0 : g1; const float k0 = up ? g1 : g0;
          g0 = k0 + __shfl_xor(s0, 4); }
        g0 += __shfl_xor(g0, 8); g0 += __shfl_xor(g0, 16); g0 += __shfl_xor(g0, 32);
        if (lane < 8) lf[((size_t)b * NFOX + lane) * SEQ + s] = log_sigmoid(g0 + bfl);
    }
}
__device__ __forceinline__ void modgate_phase(const Params& P, int l, const float* xin, LAS unsigned char* lds, int gw, int NGW, int lane) {
    stage_wf(P, l, lds, ltid());
    const float* mod = (const float*)(P.ws + WS_MOD) + (size_t)l * BATCH * 6 * DM;
    const int nrow = wave_nrows(gw, NGW); int bprev = -1;
    const float bfl = P.b_f[l * NFOX + (lane & 7)];
    f32x4 sc1[8], sh[8], va[8], vb[8];
#define MG_LOAD(V, i_) do { const int m_ = wave_row(gw, NGW, (i_)); _Pragma("unroll") for (int j = 0; j < 8; ++j) V[j] = *(const f32x4*)(xin + (size_t)m_ * DM + 256 * j + 4 * lane); __builtin_amdgcn_sched_barrier(0); } while (0)
#define MG_PROC(V, i_) do { const int m = wave_row(gw, NGW, (i_)), b = m >> 12; \
        if (b != bprev) { bprev = b; _Pragma("unroll") for (int j = 0; j < 8; ++j) { sh[j] = *(const f32x4*)(mod + (size_t)b * 6 * DM + 256 * j + 4 * lane); sc1[j] = *(const f32x4*)(mod + (size_t)b * 6 * DM + DM + 256 * j + 4 * lane) + 1.f; } } \
        modulate_row<true>(P, l, m, V, sc1, sh, lds, lane, bfl); } while (0)
    if (nrow > 0) MG_LOAD(va, 0);
#pragma unroll 1
    for (int i = 0; i < nrow; i += 2) {
        if (i + 1 < nrow) MG_LOAD(vb, i + 1);
        MG_PROC(va, i);
        if (i + 1 >= nrow) break;
        if (i + 2 < nrow) MG_LOAD(va, i + 2);
        MG_PROC(vb, i + 1);
    }
#undef MG_LOAD
#undef MG_PROC
}
template <bool GATES, bool MODULATE, bool XIN_BF, bool XOUT_BF>
__device__ __forceinline__ void ln_phase(const Params& P, const void* xres_, const bf16* y, const float* lng, const float* lnb, void* xo_, int lm, int shi, LAS unsigned char* lds, int gw, int NGW, int lane) {
    typedef typename std::conditional<XIN_BF, u32x2, f32x4>::type xin_t;
    { const int tid = ltid(); LAS float* gl = (LAS float*)(lds + 65536);
      *(LAS f32x4*)(gl + 4 * tid) = *(const f32x4*)(lng + 4 * tid); *(LAS f32x4*)(gl + DM + 4 * tid) = *(const f32x4*)(lnb + 4 * tid); }
    if constexpr (GATES) stage_wf(P, lm, lds, ltid()); else __syncthreads();
    const LAS float* gl = (const LAS float*)(lds + 65536);
    const float* mod = (const float*)(P.ws + WS_MOD) + (size_t)lm * BATCH * 6 * DM;
    const int nrow = wave_nrows(gw, NGW); int bprev = -1;
    float bfl = 0.f; if constexpr (GATES) bfl = P.b_f[lm * NFOX + (lane & 7)];
    f32x4 sc1[8], sh[8], xw[8]; xin_t xa[8], xb[8]; u32x2 ya[8], yb[8];
#define LN_LOAD(X, Y, i_) do { const int m_ = wave_row(gw, NGW, (i_)); _Pragma("unroll") for (int j = 0; j < 8; ++j) { const size_t o_ = (size_t)m_ * DM + 256 * j + 4 * lane; if constexpr (XIN_BF) X[j] = *(const xin_t*)((const bf16*)xres_ + o_); else X[j] = *(const xin_t*)((const float*)xres_ + o_); Y[j] = *(const u32x2*)(y + o_); } __builtin_amdgcn_sched_barrier(0); } while (0)
#define LN_PROC(XI, Y, i_) do { const int m = wave_row(gw, NGW, (i_)), b = m >> 12; float s = 0.f; f32x4 (&X)[8] = xw; \
        _Pragma("unroll") for (int j = 0; j < 8; ++j) { f32x4 xr_; \
            if constexpr (XIN_BF) { xr_.x = __uint_as_float(XI[j][0] << 16); xr_.y = __uint_as_float(XI[j][0] & 0xffff0000u); xr_.z = __uint_as_float(XI[j][1] << 16); xr_.w = __uint_as_float(XI[j][1] & 0xffff0000u); } \
            else { xr_.x = XI[j][0]; xr_.y = XI[j][1]; xr_.z = XI[j][2]; xr_.w = XI[j][3]; } \
            X[j].x = xr_.x * ALPHA + __uint_as_float(Y[j].x << 16); X[j].y = xr_.y * ALPHA + __uint_as_float(Y[j].x & 0xffff0000u); \
            X[j].z = xr_.z * ALPHA + __uint_as_float(Y[j].y << 16); X[j].w = xr_.w * ALPHA + __uint_as_float(Y[j].y & 0xffff0000u); \
            s += (X[j].x + X[j].y) + (X[j].z + X[j].w); } \
        if constexpr (MODULATE) { if (b != bprev) { bprev = b; _Pragma("unroll") for (int j = 0; j < 8; ++j) { sh[j] = *(const f32x4*)(mod + (size_t)b * 6 * DM + (size_t)shi * DM + 256 * j + 4 * lane); sc1[j] = *(const f32x4*)(mod + (size_t)b * 6 * DM + (size_t)(shi + 1) * DM + 256 * j + 4 * lane) + 1.f; } } } \
        const float mean = wave_sum(s) * (1.f / DM); float s2 = 0.f; \
        _Pragma("unroll") for (int j = 0; j < 8; ++j) { X[j] = X[j] - mean; s2 += (X[j].x * X[j].x + X[j].y * X[j].y) + (X[j].z * X[j].z + X[j].w * X[j].w); } \
        const float rstd = 1.f / sqrtf(wave_sum(s2) * (1.f / DM) + LN_EPS); \
        _Pragma("unroll") for (int j = 0; j < 8; ++j) { const f32x4 g_ = *(const LAS f32x4*)(gl + 256 * j + 4 * lane), b_ = *(const LAS f32x4*)(gl + DM + 256 * j + 4 * lane); \
            X[j] = X[j] * rstd * g_ + b_; const size_t o_ = (size_t)m * DM + 256 * j + 4 * lane; \
            if constexpr (XOUT_BF) { u32x2 ov_; ov_.x = cvtpk_bf16(X[j].x, X[j].y); ov_.y = cvtpk_bf16(X[j].z, X[j].w); *(u32x2*)((bf16*)xo_ + o_) = ov_; } else *(f32x4*)((float*)xo_ + o_) = X[j]; } \
        if constexpr (MODULATE) modulate_row<GATES>(P, lm, m, X, sc1, sh, lds, lane, bfl); } while (0)
    if (nrow > 0) LN_LOAD(xa, ya, 0);
#pragma unroll 1
    for (int i = 0; i < nrow; i += 2) {
        if (i + 1 < nrow) LN_LOAD(xb, yb, i + 1);
        LN_PROC(xa, ya, i);
        if (i + 1 >= nrow) break;
        if (i + 2 < nrow) LN_LOAD(xa, ya, i + 2);
        LN_PROC(xb, yb, i + 1);
    }
#undef LN_LOAD
#undef LN_PROC
}
__device__ __forceinline__ void scan_phase(const Params& P, LAS unsigned char* lds, int tid) {
    LAS double* part = (LAS double*)lds;
    const float* lf = (const float*)(P.ws + WS_LF); float* fb = (float*)(P.ws + WS_FB);
    const int lane = tid & 63, wv = tid >> 6;
    for (int q = blockIdx.x; q < BATCH * NFOX; q += gridDim.x) {
        const float* src = lf + (size_t)q * SEQ + tid * 8; double run = 0.0;
        const f32x4 a = *(const f32x4*)src, b = *(const f32x4*)(src + 4);
        double l0, l1, l2, l3, l4, l5, l6, l7;
        run += a.x; l0 = run; run += a.y; l1 = run; run += a.z; l2 = run; run += a.w; l3 = run;
        run += b.x; l4 = run; run += b.y; l5 = run; run += b.z; l6 = run; run += b.w; l7 = run;
        double inc = run;
#pragma unroll
        for (int o = 1; o < 64; o <<= 1) { const double t = __shfl_up(inc, o); if (lane >= o) inc += t; }
        if (lane == 63) part[wv] = inc;
        __syncthreads();
        double base = inc - run;
#pragma unroll
        for (int w = 0; w < NWAVES; ++w) if (w < wv) base += part[w];
        const double sc = -(double)FOX_INV_SCALE;
        f32x4 o0, o1;
        o0.x = (float)((base + l0) * sc); o0.y = (float)((base + l1) * sc); o0.z = (float)((base + l2) * sc); o0.w = (float)((base + l3) * sc);
        o1.x = (float)((base + l4) * sc); o1.y = (float)((base + l5) * sc); o1.z = (float)((base + l6) * sc); o1.w = (float)((base + l7) * sc);
        *(f32x4*)(fb + (size_t)q * SEQ + tid * 8) = o0; *(f32x4*)(fb + (size_t)q * SEQ + tid * 8 + 4) = o1;
        __syncthreads();
    }
}
__device__ __forceinline__ void combine_phase(const Params& P, int l, int gw, int NGW, int lane) {
    const float lam_init = 0.8f - 0.6f * expf(-0.3f * (float)l);
    const float d1 = wave_sum(P.lq1[l * 64 + lane] * P.lk1[l * 64 + lane]), d2 = wave_sum(P.lq2[l * 64 + lane] * P.lk2[l * 64 + lane]);
    const float lam = expf(d1) - expf(d2) + lam_init;
    const float* od = (const float*)(P.ws + WS_OD); bf16* mix = (bf16*)(P.ws + WS_MIX);
    const float g0 = P.subln_g[l * HD + 2 * lane] * (1.f - lam_init), g1 = P.subln_g[l * HD + 2 * lane + 1] * (1.f - lam_init);
    typedef float f32x2 __attribute__((ext_vector_type(2)));
#pragma unroll 1
    for (int m = gw; m < M; m += NGW) {
        const int b = m >> 12, s = m & (SEQ - 1);
        const float* base = od + (((size_t)b * 16) * SEQ + s) * HD + 2 * lane;
        f32x2 a[16];
#pragma unroll
        for (int v = 0; v < 16; ++v) a[v] = *(const f32x2*)(base + (size_t)v * SEQ * HD);
        float e0[8], e1[8], ms[8];
#pragma unroll
        for (int h = 0; h < 8; ++h) { e0[h] = a[2 * h].x - lam * a[2 * h + 1].x; e1[h] = a[2 * h].y - lam * a[2 * h + 1].y; ms[h] = e0[h] * e0[h] + e1[h] * e1[h]; }
#pragma unroll
        for (int o = 1; o < 64; o <<= 1) {
#pragma unroll
            for (int h = 0; h < 8; ++h) ms[h] += __shfl_xor(ms[h], o);
        }
#pragma unroll
        for (int h = 0; h < 8; ++h) { const float r = 1.f / sqrtf(ms[h] * (1.f / HD) + RMS_EPS);
            *(unsigned*)(mix + (size_t)m * DM + 1024 + h * HD + 2 * lane) = pk2(e0[h] * r * g0, e1[h] * r * g1); }
    }
}

struct EpiInProj {
    static constexpr bool PERM = true, AFTER_DRAIN = false;
    bf16* qkv; const float* rope;
    __device__ __forceinline__ static pg8::f32x4 xor16(pg8::f32x4 v, bool odd) {
        pg8::f32x4 r;
#pragma unroll
        for (int e = 0; e < 4; ++e) { auto s = __builtin_amdgcn_permlane16_swap(__float_as_uint(v[e]), __float_as_uint(v[e]), false, false); r[e] = __uint_as_float(odd ? s[0] : s[1]); }
        return r;
    }
    __device__ __forceinline__ void operator()(const pg8::f32x4 (&acc)[2][2][4][2], const pg8::Unit& u, int wr, int wc, int fr, int fq) const {
        const int seg = u.pn >> 2, cs0 = (u.pn & 3) * 256;
        bf16* base = qkv + (size_t)seg * ((size_t)M * 1024);
        const bool ropeseg = (seg == 3 || seg == 4), do_rope = ropeseg && ((wc & 1) == 0);
        const int rowb = u.pm * 256 + wr * 64 + fr;
        pg8::f32x4 nc0, nc1, ns0, ns1;
        if (do_rope) { const float* rp = rope + (size_t)rowb * 16; nc0 = *(const pg8::f32x4*)rp; nc1 = *(const pg8::f32x4*)(rp + 4); ns0 = *(const pg8::f32x4*)(rp + 8); ns1 = *(const pg8::f32x4*)(rp + 12); }
#pragma unroll
        for (int idx = 0; idx < 8; ++idx) {
                const int ai = idx >> 2, m = idx & 3;
                const int row = rowb + ai * 128 + m * 16, b = row >> 12, s = row & (SEQ - 1);
                const pg8::f32x4 c0 = nc0, c1 = nc1, s0 = ns0, s1 = ns1;
                if (do_rope && idx < 7) { const int rn = rowb + ((idx + 1) >> 2) * 128 + ((idx + 1) & 3) * 16; const float* rp = rope + (size_t)rn * 16;
                    nc0 = *(const pg8::f32x4*)rp; nc1 = *(const pg8::f32x4*)(rp + 4); ns0 = *(const pg8::f32x4*)(rp + 8); ns1 = *(const pg8::f32x4*)(rp + 12); }
#pragma unroll
                for (int bj = 0; bj < 2; ++bj) {
                    const int cs = cs0 + bj * 128 + wc * 32 + 8 * fq;
                    pg8::f32x4 v0 = acc[ai][bj][m][0], v1 = acc[ai][bj][m][1];
                    if (do_rope) {
                        const pg8::f32x4 p0 = xor16(v0, fq & 1), p1 = xor16(v1, fq & 1);
                        if (fq < 2) { const float sg = fq == 0 ? -1.f : 1.f; v0 = v0 * c0 + (p0 * s0) * sg; v1 = v1 * c1 + (p1 * s1) * sg; }
                    }
                    pg8::u32x4 w; w.x = pg8::cvt_pk_bf16(v0[0], v0[1]); w.y = pg8::cvt_pk_bf16(v0[2], v0[3]); w.z = pg8::cvt_pk_bf16(v1[0], v1[1]); w.w = pg8::cvt_pk_bf16(v1[2], v1[3]);
                    bf16* dst = ropeseg ? base + (((size_t)(b * 16 + (cs >> 6)) * SEQ + s) * 64 + (cs & 63))
                                        : base + (((size_t)(b * 8 + (cs >> 7)) * SEQ + s) * 128 + (cs & 127));
                    *(pg8::u32x4*)dst = w;
                }
        }
    }
};
struct EpiRelu2 {
    static constexpr bool PERM = true, AFTER_DRAIN = false;
    bf16* U;
    __device__ __forceinline__ void operator()(const pg8::f32x4 (&acc)[2][2][4][2], const pg8::Unit& u, int wr, int wc, int fr, int fq) const {
        const int row0 = u.pm * 256 + wr * 64 + fr, col0 = u.pn * 256 + wc * 32 + 8 * fq;
#pragma unroll
        for (int ai = 0; ai < 2; ++ai)
#pragma unroll
            for (int m = 0; m < 4; ++m) { bf16* rowp = U + (size_t)(row0 + ai * 128 + m * 16) * DFF + col0;
#pragma unroll
                for (int bj = 0; bj < 2; ++bj) { pg8::f32x4 v0 = acc[ai][bj][m][0], v1 = acc[ai][bj][m][1];
#pragma unroll
                    for (int e = 0; e < 4; ++e) { const float a = fmaxf(v0[e], 0.f), c = fmaxf(v1[e], 0.f); v0[e] = a * a; v1[e] = c * c; }
                    pg8::u32x4 w; w.x = pg8::cvt_pk_bf16(v0[0], v0[1]); w.y = pg8::cvt_pk_bf16(v0[2], v0[3]); w.z = pg8::cvt_pk_bf16(v1[0], v1[1]); w.w = pg8::cvt_pk_bf16(v1[2], v1[3]);
                    *(pg8::u32x4*)(rowp + bj * 128) = w; } }
    }
};
struct EpiGate {
    static constexpr bool PERM = true, AFTER_DRAIN = false;
    bf16* Y; const float* gate;
    __device__ __forceinline__ void operator()(const pg8::f32x4 (&acc)[2][2][4][2], const pg8::Unit& u, int wr, int wc, int fr, int fq) const {
        const int row0 = u.pm * 256 + wr * 64 + fr, col0 = u.pn * 256 + wc * 32 + 8 * fq, b = (u.pm * 256) >> 12;
        pg8::f32x4 gv[2][2];
#pragma unroll
        for (int bj = 0; bj < 2; ++bj)
#pragma unroll
            for (int n = 0; n < 2; ++n) gv[bj][n] = *(const pg8::f32x4*)(gate + (size_t)b * 6 * DM + col0 + bj * 128 + 4 * n) + 1.f;
#pragma unroll
        for (int ai = 0; ai < 2; ++ai)
#pragma unroll
            for (int m = 0; m < 4; ++m) { bf16* rowp = Y + (size_t)(row0 + ai * 128 + m * 16) * DM + col0;
#pragma unroll
                for (int bj = 0; bj < 2; ++bj) { const pg8::f32x4 v0 = acc[ai][bj][m][0] * gv[bj][0], v1 = acc[ai][bj][m][1] * gv[bj][1];
                    pg8::u32x4 w; w.x = pg8::cvt_pk_bf16(v0[0], v0[1]); w.y = pg8::cvt_pk_bf16(v0[2], v0[3]); w.z = pg8::cvt_pk_bf16(v1[0], v1[1]); w.w = pg8::cvt_pk_bf16(v1[2], v1[3]);
                    *(pg8::u32x4*)(rowp + bj * 128) = w; } }
    }
};

template <int DQK, bool BIAS, class TOut, int OST> struct AttnRef {
    unsigned char* ws; int jlo0, jlo1; float lam, gmul; const float* gsub;
    __device__ __forceinline__ int jlo_of(int step) const { return step ? jlo1 : jlo0; }
    __device__ __forceinline__ att::BlockRef<TOut> operator()(int L, int step) const {
        const int bh = 4 * (L & 7) + (L >> 6), x = (L >> 3) & 7;
        att::BlockRef<TOut> r;
        const bf16* qkv = (const bf16*)(ws + WS_QKV); const size_t SEG = (size_t)M * 1024;
        const int b = bh >> 3, h = bh & 7;
        if constexpr (BIAS) {
            const int qb = step ? 15 - x : x;
            r.Q = qkv + ((size_t)bh * SEQ + (size_t)qb * 256) * 128; r.K = qkv + SEG + (size_t)bh * SEQ * 128; r.V = qkv + 2 * SEG + (size_t)bh * SEQ * 128;
            r.Fb = (const float*)(ws + WS_FB) + (size_t)bh * SEQ;
            r.O = (TOut*)(ws + WS_MIX) + ((size_t)b * SEQ + (size_t)qb * 256) * OST + h * 128; r.MX = nullptr; r.comp = 0; r.P0 = qb * 256;
        } else {
            const int comp = step & 1, qb = (step >> 1) ? 15 - x : x, vh = b * 16 + 2 * h + comp;
            r.Q = qkv + 3 * SEG + ((size_t)vh * SEQ + (size_t)qb * 256) * 64; r.K = qkv + 4 * SEG + (size_t)vh * SEQ * 64; r.V = qkv + 5 * SEG + (size_t)bh * SEQ * 128;
            r.Fb = nullptr;
            r.O = (TOut*)(ws + WS_OD) + ((size_t)bh * SEQ + (size_t)qb * 256) * OST;
            r.MX = (bf16*)(ws + WS_MIX) + ((size_t)b * SEQ + (size_t)qb * 256) * DM + 1024 + h * 128; r.comp = comp; r.P0 = qb * 256;
        }
        return r;
    }
};
__device__ __forceinline__ float rows_maxnorm2(const bf16* base, int nrows, float* scr, int tid) {
    const int lane = tid & 63, wid = tid >> 6;
    float mx = 0.f;
    for (int r0 = wid * 4; r0 < nrows; r0 += 8 * 4 * 32) {
        u32x4 v[32];
#pragma unroll
        for (int i = 0; i < 32; ++i) { const int r = r0 + 32 * i + (lane >> 4); v[i] = (r < nrows) ? *(const u32x4*)(base + (size_t)r * 128 + (lane & 15) * 8) : (u32x4){0u, 0u, 0u, 0u}; }
#pragma unroll
        for (int i = 0; i < 32; ++i) { float s = 0.f;
#pragma unroll
            for (int e = 0; e < 4; ++e) { const float lo = __uint_as_float(v[i][e] << 16), hi = __uint_as_float(v[i][e] & 0xffff0000u); s += lo * lo + hi * hi; }
            mx = fmaxf(mx, att::row16_sum(s)); }
    }
    __syncthreads();
    if ((lane & 15) == 0) scr[wid * 4 + (lane >> 4)] = mx;
    __syncthreads();
    float r = scr[0];
#pragma unroll
    for (int w = 1; w < NWAVES * 4; ++w) r = fmaxf(r, scr[w]);
    return r;
}
__device__ __forceinline__ void rows_qstats(const bf16* qrows, const bf16* krows, float* scr, int tid, float& dmin, float& q2max) {
    const int lane = tid & 63, wid = tid >> 6;
    float mn = 3.0e38f, mx = 0.f;
    u32x4 qv[8], kv[8];
#pragma unroll
    for (int i = 0; i < 8; ++i) { const int r = wid * 32 + 4 * i + (lane >> 4); qv[i] = *(const u32x4*)(qrows + (size_t)r * 128 + (lane & 15) * 8); kv[i] = *(const u32x4*)(krows + (size_t)r * 128 + (lane & 15) * 8); }
#pragma unroll
    for (int i = 0; i < 8; ++i) { float s = 0.f, n = 0.f;
#pragma unroll
        for (int e = 0; e < 4; ++e) { const float ql = __uint_as_float(qv[i][e] << 16), qh = __uint_as_float(qv[i][e] & 0xffff0000u);
            s += ql * __uint_as_float(kv[i][e] << 16) + qh * __uint_as_float(kv[i][e] & 0xffff0000u); n += ql * ql + qh * qh; }
        mn = fminf(mn, att::row16_sum(s)); mx = fmaxf(mx, att::row16_sum(n)); }
    __syncthreads();
    if ((lane & 15) == 0) { scr[wid * 4 + (lane >> 4)] = mn; scr[32 + wid * 4 + (lane >> 4)] = mx; }
    __syncthreads();
    float r0 = scr[0], r1 = scr[32];
#pragma unroll
    for (int w = 1; w < NWAVES * 4; ++w) { r0 = fminf(r0, scr[w]); r1 = fmaxf(r1, scr[32 + w]); }
    dmin = r0; q2max = r1;
}
template <int DQK, bool BIAS, class TOut, int OST>
__device__ __forceinline__ void attn_stream(const Params& P, int l, char* lds, int total) {
    int L = blockIdx.x; if (L >= total) return;
    const int stride = gridDim.x;
    AttnRef<DQK, BIAS, TOut, OST> rf{P.ws, 0, 0, 0.f, 0.f, nullptr};
    att::Seam<DQK> S;
    if constexpr (BIAS) {
        for (;;) {
            { const int tid = ltid(); float* scr = (float*)(lds + att::OFF_WS);
              const att::BlockRef<TOut> b0 = rf(L, 0), b1 = rf(L, 1);
              const float kmax = sqrtf(rows_maxnorm2(b0.K, b1.P0 + 256, scr, tid)) * 1.0001f;
              float d0, d1, q20, q21;
              rows_qstats(b0.Q, b0.K + (size_t)b0.P0 * 128, scr, tid, d0, q20); rows_qstats(b1.Q, b1.K + (size_t)b1.P0 * 128, scr, tid, d1, q21);
              const float q0 = sqrtf(q20) * 1.0001f, q1 = sqrtf(q21) * 1.0001f;
              const float thr0 = q0 * kmax - d0 + fabsf(d0) * 1e-4f + 24.f * FOX_INV_SCALE, thr1 = q1 * kmax - d1 + fabsf(d1) * 1e-4f + 24.f * FOX_INV_SCALE;
              rf.jlo0 = att::fox_jlo(b0.Fb, b0.P0, thr0, tid & 63); rf.jlo1 = att::fox_jlo(b1.Fb, b1.P0, thr1, tid & 63);
              __syncthreads(); }
            { const att::BlockRef<TOut> cur = rf(L, 0); att::causal_prime<DQK, BIAS, TOut>(cur, rf.jlo0, lds, S); }
            att::causal_block<DQK, BIAS, TOut, OST>(rf, L, 0, L, 1, lds, S);
            att::causal_block<DQK, BIAS, TOut, OST>(rf, L, 1, L, 1, lds, S);
            if (L + stride >= total) break;
            L += stride; __syncthreads();
        }
    } else {
        { const int lane = ltid() & 63;
          const float lam_init = 0.8f - 0.6f * expf(-0.3f * (float)l);
          const float d1 = wave_sum(P.lq1[l * 64 + lane] * P.lk1[l * 64 + lane]), d2 = wave_sum(P.lq2[l * 64 + lane] * P.lk2[l * 64 + lane]);
          rf.lam = expf(d1) - expf(d2) + lam_init; rf.gmul = 1.f - lam_init; rf.gsub = P.subln_g + l * HD; }
        { const att::BlockRef<TOut> cur = rf(L, 0); att::causal_prime<DQK, BIAS, TOut>(cur, 0, lds, S); }
        int step = 0;
#pragma unroll 1
        for (;;) {
            int Ln = L, sn = step + 1;
            if (sn == 4) { if (L + stride < total) { Ln = L + stride; sn = 0; } else { sn = 3; } }
            const bool last = (step == 3) && (Ln == L);
            att::causal_block<DQK, BIAS, TOut, OST>(rf, L, step, Ln, sn, lds, S);
            if (last) break;
            L = Ln; step = sn;
        }
    }
}

#ifndef REP_LN1
#define REP_LN1 1
#endif
#ifndef REP_LN2
#define REP_LN2 1
#endif
#ifndef REP_P0
#define REP_P0 1
#endif
#ifndef REP_CV
#define REP_CV 1
#endif
#ifndef REP_MG
#define REP_MG 1
#endif
#ifndef REP_R
#define REP_R 1
#endif
#ifndef REP_S
#define REP_S 1
#endif
#define GSYNC() do { for (int rs_ = 0; rs_ < REP_S; ++rs_) xcd_barrier(xbar); } while (0)
#ifndef REP_G
#define REP_G 1
#endif
#ifndef REP_FOX
#define REP_FOX 1
#endif
#ifndef REP_A
#define REP_A 1
#endif
__device__ __forceinline__ Params load_params() {
#if defined(__HIP_DEVICE_COMPILE__)
    typedef const __attribute__((address_space(4))) Params* CP;
    CP p = (CP)__builtin_amdgcn_kernarg_segment_ptr();
    asm volatile("" : "+s"(p));
    return *p;
#else
    return Params{};
#endif
}
__global__ void __launch_bounds__(NTHREADS) fwd_megakernel(Params P_arg) {
    extern __shared__ __attribute__((aligned(16))) unsigned char lds_raw[];
    cg::grid_group grid = cg::this_grid();
    LAS unsigned char* lds = (LAS unsigned char*)lds_raw;
    const int G = gridDim.x, NGW = G * NWAVES;
    volatile LAS unsigned* xb_st = (volatile LAS unsigned*)(lds + 131072 + 256);
    if (threadIdx.x < 2) xb_st[threadIdx.x] = 0u;
    __syncthreads();
    XcdBarrier xbar;
    { const Params P = load_params(); xbar = xcd_barrier_post((unsigned*)(P.ws + WS_BAR), xb_st); }
#define PH_IDS() const Params P = load_params(); unsigned char* ws = P.ws; (void)ws; const int tid = ltid(), lane = tid & 63, wave = __builtin_amdgcn_readfirstlane(tid >> 6), gw = blockIdx.x * NWAVES + wave; (void)lane; (void)gw

    for (int rr_ = 0; rr_ < REP_R * REP_P0; ++rr_) { PH_IDS(); adaln_phase(P, lds, tid); }
    for (int rr_ = 0; rr_ < REP_R; ++rr_) { PH_IDS(); rope_phase(P, blockIdx.x * NTHREADS + tid, G * NTHREADS); }
    for (int rr_ = 0; rr_ < REP_R * REP_P0; ++rr_) { PH_IDS(); convert_weights(P, 0, lds, gw, NGW, wave, lane); }
    grid.sync();
    for (int rr_ = 0; rr_ < REP_R * REP_MG; ++rr_) { PH_IDS(); modgate_phase(P, 0, P.x, lds, gw, NGW, lane); }
    GSYNC();

#pragma unroll 1
    for (int l = 0; l < DEPTH; ++l) {
        for (int rr_ = 0; rr_ < REP_R; ++rr_) { PH_IDS(); scan_phase(P, lds, tid); }
        __syncthreads();
#ifndef NO_G1
        for (int rep_ = 0; rep_ < REP_G; ++rep_)
        { const Params P = load_params(); unsigned char* ws = P.ws;
          pg8::Gemm g{(const pg8::bf16_t*)(ws + WS_H), (const pg8::bf16_t*)(ws + WS_WIN), M, NQKV, DM}; pg8::StaticOrder S; S.init(M, NQKV, G, (int)blockIdx.x);
          EpiInProj E{(bf16*)(ws + WS_QKV), (const float*)(ws + WS_ROPE)};
          pg8::gemm_phase<EpiInProj, pg8::StaticOrder, true, true>(lds, g, S, E); }
#endif
        GSYNC();
        for (int rep_ = 0; rep_ < REP_A; ++rep_) {
#ifndef NO_A1
        for (int rf_ = 0; rf_ < REP_FOX; ++rf_) { const Params P = load_params(); attn_stream<128, true, bf16, DM>(P, l, (char*)lds_raw, BATCH * NFOX * 8); __syncthreads(); }
#endif
        __syncthreads();
#ifndef NO_A2
        { const Params P = load_params(); attn_stream<64, false, float, 128>(P, l, (char*)lds_raw, BATCH * NDIFF * 8); }
#endif
        __syncthreads(); }
        GSYNC();
#ifndef NO_G2
        for (int rep_ = 0; rep_ < REP_G; ++rep_)
        { const Params P = load_params(); unsigned char* ws = P.ws; const float* modl = (const float*)(ws + WS_MOD) + (size_t)l * BATCH * 6 * DM;
          pg8::Gemm g{(const pg8::bf16_t*)(ws + WS_MIX), (const pg8::bf16_t*)(ws + WS_WO), M, DM, DM}; pg8::StaticOrder S; S.init(M, DM, G, (int)blockIdx.x);
          EpiGate E{(bf16*)(ws + WS_Z), modl + 2 * DM};
          pg8::gemm_phase<EpiGate, pg8::StaticOrder, true, true>(lds, g, S, E); }
#endif
        GSYNC();
        for (int rr_ = 0; rr_ < REP_R * REP_LN1; ++rr_) { PH_IDS();
            if (l == 0) ln_phase<false, true, false, true>(P, P.x, (const bf16*)(ws + WS_Z), P.ln1_g + l * DM, P.ln1_b + l * DM, ws + WS_XA, l, 3, lds, gw, NGW, lane);
            else        ln_phase<false, true, true, true>(P, ws + WS_X2, (const bf16*)(ws + WS_Z), P.ln1_g + l * DM, P.ln1_b + l * DM, ws + WS_XA, l, 3, lds, gw, NGW, lane); }
        GSYNC();
#ifndef NO_G3
        for (int rep_ = 0; rep_ < REP_G; ++rep_)
        { const Params P = load_params(); unsigned char* ws = P.ws;
          pg8::Gemm g{(const pg8::bf16_t*)(ws + WS_H), (const pg8::bf16_t*)(ws + WS_WUP), M, DFF, DM}; pg8::StaticOrder S; S.init(M, DFF, G, (int)blockIdx.x);
          EpiRelu2 E{(bf16*)(ws + WS_U)};
          pg8::gemm_phase<EpiRelu2, pg8::StaticOrder, true, true>(lds, g, S, E); }
#endif
        GSYNC();
#ifndef NO_G4
        for (int rep_ = 0; rep_ < REP_G; ++rep_)
        { const Params P = load_params(); unsigned char* ws = P.ws; const float* modl = (const float*)(ws + WS_MOD) + (size_t)l * BATCH * 6 * DM;
          pg8::Gemm g{(const pg8::bf16_t*)(ws + WS_U), (const pg8::bf16_t*)(ws + WS_WDN), M, DM, DFF}; pg8::StaticOrder S; S.init(M, DM, G, (int)blockIdx.x);
          EpiGate E{(bf16*)(ws + WS_Z), modl + 5 * DM};
          pg8::gemm_phase<EpiGate, pg8::StaticOrder, true, true>(lds, g, S, E); }
#endif
        GSYNC();
        if (l + 1 < DEPTH) {
            for (int rr_ = 0; rr_ < REP_R * REP_CV; ++rr_) { PH_IDS(); convert_weights(P, l + 1, lds, gw, NGW, wave, lane); }
            __syncthreads();
            for (int rr_ = 0; rr_ < REP_R * REP_LN2; ++rr_) { PH_IDS(); ln_phase<true, true, true, true>(P, ws + WS_XA, (const bf16*)(ws + WS_Z), P.ln2_g + l * DM, P.ln2_b + l * DM, ws + WS_X2, l + 1, 0, lds, gw, NGW, lane); }
            GSYNC();
        } else {
            for (int rr_ = 0; rr_ < REP_R * REP_LN2; ++rr_) { PH_IDS(); ln_phase<false, false, true, false>(P, ws + WS_XA, (const bf16*)(ws + WS_Z), P.ln2_g + l * DM, P.ln2_b + l * DM, P.out, l, 0, lds, gw, NGW, lane); }
        }
    }
}

extern "C" void kernel_launch(void* const* d_in, const int* in_sizes, int n_in, void* d_out, int out_size, void* d_ws, size_t ws_size, hipStream_t stream) {
    static int grid = 0;
    if (grid == 0) {
        if (n_in != 19 || in_sizes[0] != M * DM || out_size != M * DM || ws_size < WS_END) {
            fprintf(stderr, "kernel_launch: unexpected shapes (n_in %d, in0 %d, out %d, ws %zu; need ws >= %zu); nothing launched\n", n_in, n_in > 0 ? in_sizes[0] : -1, out_size, ws_size, (size_t)WS_END);
            grid = -1; return; }
        int dev = 0, cus = 0, per_cu = 0;
        (void)hipGetDevice(&dev);
        (void)hipDeviceGetAttribute(&cus, hipDeviceAttributeMultiprocessorCount, dev);
        if (hipFuncSetAttribute((const void*)fwd_megakernel, hipFuncAttributeMaxDynamicSharedMemorySize, LDS_BYTES) != hipSuccess) { fprintf(stderr, "kernel_launch: hipFuncSetAttribute failed\n"); grid = -1; return; }
        if (hipOccupancyMaxActiveBlocksPerMultiprocessor(&per_cu, (const void*)fwd_megakernel, NTHREADS, LDS_BYTES) != hipSuccess || per_cu < 1) { fprintf(stderr, "kernel_launch: occupancy query says %d\n", per_cu); per_cu = 1; }
        (void)hipGetLastError();
        grid = cus * per_cu;
        if (grid <= 0) grid = 256;
    }
    if (grid < 0) return;
    Params p{};
    p.x = (const float*)d_in[0]; p.c = (const float*)d_in[1]; p.pos = (const int*)d_in[2]; p.w_ada = (const float*)d_in[3]; p.b_ada = (const float*)d_in[4];
    p.w_in = (const float*)d_in[5]; p.b_f = (const float*)d_in[6]; p.lq1 = (const float*)d_in[7]; p.lk1 = (const float*)d_in[8]; p.lq2 = (const float*)d_in[9];
    p.lk2 = (const float*)d_in[10]; p.subln_g = (const float*)d_in[11]; p.w_o = (const float*)d_in[12]; p.ln1_g = (const float*)d_in[13]; p.ln1_b = (const float*)d_in[14];
    p.w_up = (const float*)d_in[15]; p.w_down = (const float*)d_in[16]; p.ln2_g = (const float*)d_in[17]; p.ln2_b = (const float*)d_in[18];
    p.out = (float*)d_out; p.ws = (unsigned char*)d_ws;
    if (hipMemsetAsync((char*)d_ws + WS_BAR, 0, 16384, stream) != hipSuccess) { fprintf(stderr, "kernel_launch: hipMemsetAsync failed\n"); return; }
    void* args[] = {&p};
    hipError_t e = hipLaunchCooperativeKernel((const void*)fwd_megakernel, dim3(grid), dim3(NTHREADS), args, LDS_BYTES, stream);
    if (e != hipSuccess) fprintf(stderr, "kernel_launch: cooperative launch failed: %s (grid %d)\n", hipGetErrorString(e), grid);
}
```

```cpp
#include <hip/hip_runtime.h>
#include <hip/hip_cooperative_groups.h>
#include <cstdio>
#include <cstdint>
namespace cg = cooperative_groups;
__device__ __forceinline__ int ltid() { int t = threadIdx.x; asm volatile("" : "+v"(t)); return t; }
namespace pg8 {
#define PG8_LAS __attribute__((address_space(3)))
typedef unsigned short bf16_t;
typedef short bf16x8 __attribute__((ext_vector_type(8)));
typedef float f32x4 __attribute__((ext_vector_type(4)));
typedef unsigned u32x4 __attribute__((ext_vector_type(4)));
constexpr int BM = 256, BK = 64, HALF = 128, HTB = HALF * BK * 2  , STAGE_BYTES = 8 * HTB, NXCD = 8, WGM = 8;

__host__ __device__ __forceinline__ int lds_byte(int r, int c) { const int st = (r >> 4) * 2 + (c >> 5), rr = r & 15, cc = c & 31, ob = rr * 64 + cc * 2; return st * 1024 + (ob ^ (((ob >> 9) & 1) << 5)); }
__host__ __device__ __forceinline__ void stage_rc(int b, int& R, int& C) { const int st = b / 1024, sb = b % 1024, swz = sb ^ (((sb >> 9) & 1) << 5); R = (st >> 1) * 16 + swz / 64; C = (st & 1) * 32 + (swz % 64) / 2; }
__host__ __device__ __forceinline__ int perm32(int rho) { const int n = rho >> 4, i = rho & 15; return 8 * (i >> 2) + 4 * n + (i & 3); }

struct Unit { int pm, pn; };
struct Gemm { const bf16_t* A; const bf16_t* Bt; int M, N, K; };

struct StaticOrder {
    int nM, nN, nwg, G, c;
    __host__ __device__ void init(int M, int N, int G_, int c_) { nM = M / BM; nN = N / BM; nwg = nM * nN; G = G_; c = c_; }
    __host__ __device__ bool next(int i, Unit& u) const {
        const long L = (long)i * G + c; if (L >= nwg) return false;
        int wgid = (int)L; { const int q = nwg / NXCD, r = nwg % NXCD, xcd = wgid % NXCD, off = wgid / NXCD; wgid = (xcd < r ? xcd * (q + 1) : r * (q + 1) + (xcd - r) * q) + off; }
        const int nig = WGM * nN, gid = wgid / nig, fm = gid * WGM, gsz = (nM - fm) < WGM ? (nM - fm) : WGM;
        u.pm = fm + ((wgid % nig) % gsz); u.pn = (wgid % nig) / gsz; return true;
    }
    __device__ __forceinline__ void a_ready(const Unit&) const {}
    __device__ __forceinline__ void done(const Unit&) const {}
};
__device__ __forceinline__ unsigned cvt_pk_bf16(float lo, float hi) { unsigned r; asm volatile("v_cvt_pk_bf16_f32 %0, %1, %2" : "=v"(r) : "v"(lo), "v"(hi)); return r; }
typedef float f32x2 __attribute__((ext_vector_type(2)));
template <class Epi, class Sched, bool ALIGN_EPI = false, bool SP2 = false>
__device__ __forceinline__ void gemm_phase(PG8_LAS unsigned char* lds, const Gemm g, const Sched& S, const Epi& E) {
    const int tid = ltid(), wid = __builtin_amdgcn_readfirstlane(tid >> 6), lane = tid & 63, wr = wid >> 2, wc = wid & 3, fr = lane & 15, fq = lane >> 4;
    const int K = g.K, nt = K / BK;
    unsigned voffA[2], voffB[2];
#pragma unroll
    for (int i = 0; i < 2; ++i) { int R, C; stage_rc(tid * 16 + i * 8192, R, C); const int Rb = Epi::PERM ? ((R & ~31) + perm32(R & 31)) : R;
        voffA[i] = (unsigned)(R * K + C) * 2u; voffB[i] = (unsigned)(Rb * K + C) * 2u; }
    const size_t kstep = (size_t)(BK * 2);
    const size_t hstep = (size_t)HALF * K * 2;
    const size_t tstep = 2 * hstep;
    const unsigned ldsw = (unsigned)wid * 1024u;
    const int aoff = lds_byte(wr * 64 + fr, fq * 8), boff = lds_byte(wc * 32 + fr, fq * 8);
#define PG8_SA(b, h) (((b) * 2 + (h)) * HTB)
#define PG8_SB(b, h) ((4 + (b) * 2 + (h)) * HTB)
#define PG8_STAGE(bufoff, gbase, voff) do { _Pragma("unroll") for (int _i = 0; _i < 2; ++_i) \
        __builtin_amdgcn_global_load_lds((const unsigned*)((const char*)(gbase) + (voff)[_i]), (PG8_LAS unsigned*)(lds + (bufoff) + ldsw + _i * 8192), 16, 0, 0); } while (0)
#define PG8_LDA(dst, b, h) do { _Pragma("unroll") for (int m = 0; m < 4; ++m) _Pragma("unroll") for (int k = 0; k < 2; ++k) dst[m][k] = *(const PG8_LAS bf16x8*)(lds + PG8_SA(b, h) + aoff + m * 2048 + k * 1024); } while (0)
#define PG8_LDB(dst, b, h) do { _Pragma("unroll") for (int n = 0; n < 2; ++n) _Pragma("unroll") for (int k = 0; k < 2; ++k) dst[n][k] = *(const PG8_LAS bf16x8*)(lds + PG8_SB(b, h) + boff + n * 2048 + k * 1024); } while (0)
#define PG8_MMA(ai, bj, At, Bt) do { __builtin_amdgcn_s_setprio(1); _Pragma("unroll") for (int m = 0; m < 4; ++m) _Pragma("unroll") for (int n = 0; n < 2; ++n) _Pragma("unroll") for (int k = 0; k < 2; ++k) \
        acc[ai][bj][m][n] = __builtin_amdgcn_mfma_f32_16x16x32_bf16(Bt[n][k], At[m][k], acc[ai][bj][m][n], 0, 0, 0); __builtin_amdgcn_s_setprio(0); } while (0)
#define PG8_WAIT_V(n) asm volatile("s_waitcnt vmcnt(" #n ")" ::: "memory")
#define PG8_WAIT_L(n) asm volatile("s_waitcnt lgkmcnt(" #n ")" ::: "memory")
#define PG8_BAR __builtin_amdgcn_s_barrier()
#define PG8_SCHED __builtin_amdgcn_sched_barrier(0)
    Unit cur, nxt; int ui = 0;
    if (!S.next(0, cur)) return;
    f32x4 acc[2][2][4][2];
#pragma unroll
    for (int a = 0; a < 2; ++a)
#pragma unroll
        for (int b = 0; b < 2; ++b)
#pragma unroll
            for (int m = 0; m < 4; ++m)
#pragma unroll
                for (int n = 0; n < 2; ++n) acc[a][b][m][n] = (f32x4){0.f, 0.f, 0.f, 0.f};
    bf16x8 At[4][2], B0[2][2], B1[2][2];
    const char* cA = (const char*)g.A + (size_t)cur.pm * tstep; const char* cB = (const char*)g.Bt + (size_t)cur.pn * tstep;
    S.a_ready(cur);
    if constexpr (SP2) {
        PG8_STAGE(PG8_SB(0, 0), cB, voffB); PG8_STAGE(PG8_SB(0, 1), cB + hstep, voffB); PG8_STAGE(PG8_SA(0, 0), cA, voffA); PG8_STAGE(PG8_SA(0, 1), cA + hstep, voffA);
        if (wr == 1) PG8_BAR;
        PG8_WAIT_V(2); PG8_BAR;
        PG8_STAGE(PG8_SB(1, 0), cB + kstep, voffB); PG8_STAGE(PG8_SA(1, 0), cA + kstep, voffA); PG8_STAGE(PG8_SB(1, 1), cB + hstep + kstep, voffB);
        PG8_WAIT_V(6); PG8_BAR;
    } else {
        PG8_STAGE(PG8_SB(0, 0), cB, voffB); PG8_STAGE(PG8_SA(0, 0), cA, voffA); PG8_STAGE(PG8_SB(0, 1), cB + hstep, voffB); PG8_STAGE(PG8_SA(0, 1), cA + hstep, voffA);
        if (wr == 1) PG8_BAR;
        PG8_WAIT_V(4); PG8_BAR;
        PG8_STAGE(PG8_SB(1, 0), cB + kstep, voffB); PG8_STAGE(PG8_SA(1, 0), cA + kstep, voffA); PG8_STAGE(PG8_SB(1, 1), cB + hstep + kstep, voffB);
        PG8_WAIT_V(6); PG8_BAR;
    }
    for (;;) {
        const bool has_next = S.next(ui + 1, nxt);
        const char* nA = has_next ? (const char*)g.A + (size_t)nxt.pm * tstep : cA; const char* nB = has_next ? (const char*)g.Bt + (size_t)nxt.pn * tstep : cB;
        for (int t = 0; t < nt; t += 2) {
            const bool last = (t == nt - 2);
            const char* a1 = cA + (size_t)(t + 1) * kstep;
            const char* a2 = last ? nA : cA + (size_t)(t + 2) * kstep; const char* b2 = last ? nB : cB + (size_t)(t + 2) * kstep;
            const char* a3 = a2 + kstep; const char* b3 = b2 + kstep;
            if (last && has_next) S.a_ready(nxt);
            if constexpr (SP2) {
            PG8_LDB(B0, 0, 0); PG8_LDB(B1, 0, 1); PG8_SCHED; PG8_LDA(At, 0, 0); PG8_STAGE(PG8_SA(1, 1), a1 + hstep, voffA);
            PG8_WAIT_V(8); PG8_WAIT_L(0); PG8_BAR; PG8_MMA(0, 0, At, B0); PG8_MMA(0, 1, At, B1); PG8_BAR; PG8_SCHED;
            PG8_LDA(At, 0, 1); PG8_STAGE(PG8_SB(0, 0), b2, voffB); PG8_STAGE(PG8_SB(0, 1), b2 + hstep, voffB); PG8_STAGE(PG8_SA(0, 0), a2, voffA);
            PG8_WAIT_V(8); PG8_WAIT_L(0); PG8_BAR; PG8_MMA(1, 0, At, B0); PG8_MMA(1, 1, At, B1); PG8_BAR; PG8_SCHED;
            PG8_LDB(B0, 1, 0); PG8_LDB(B1, 1, 1); PG8_SCHED; PG8_LDA(At, 1, 0); PG8_STAGE(PG8_SA(0, 1), a2 + hstep, voffA);
            PG8_WAIT_V(8); PG8_WAIT_L(0); PG8_BAR; PG8_MMA(0, 0, At, B0); PG8_MMA(0, 1, At, B1); PG8_BAR; PG8_SCHED;
            PG8_LDA(At, 1, 1); PG8_STAGE(PG8_SB(1, 0), b3, voffB); PG8_STAGE(PG8_SB(1, 1), b3 + hstep, voffB); PG8_STAGE(PG8_SA(1, 0), a3, voffA);
            PG8_WAIT_V(8); PG8_WAIT_L(0); PG8_BAR; PG8_MMA(1, 0, At, B0); PG8_MMA(1, 1, At, B1); PG8_BAR; PG8_SCHED;
            } else {
            PG8_LDB(B0, 0, 0); PG8_SCHED; PG8_LDA(At, 0, 0); PG8_STAGE(PG8_SA(1, 1), a1 + hstep, voffA);
            PG8_WAIT_L(8); PG8_BAR; PG8_WAIT_L(0); PG8_MMA(0, 0, At, B0); PG8_BAR; PG8_SCHED;
            PG8_LDB(B1, 0, 1); PG8_STAGE(PG8_SB(0, 0), b2, voffB);
            PG8_BAR; PG8_WAIT_L(0); PG8_MMA(0, 1, At, B1); PG8_BAR;
            PG8_LDA(At, 0, 1); PG8_STAGE(PG8_SA(0, 0), a2, voffA);
            PG8_BAR; PG8_WAIT_L(0); PG8_MMA(1, 0, At, B0); PG8_BAR; PG8_SCHED;
            PG8_STAGE(PG8_SB(0, 1), b2 + hstep, voffB);
            PG8_WAIT_V(6); PG8_BAR; PG8_MMA(1, 1, At, B1); PG8_BAR;
            PG8_LDB(B0, 1, 0); PG8_SCHED; PG8_LDA(At, 1, 0); PG8_STAGE(PG8_SA(0, 1), a2 + hstep, voffA);
            PG8_WAIT_L(8); PG8_BAR; PG8_WAIT_L(0); PG8_MMA(0, 0, At, B0); PG8_BAR; PG8_SCHED;
            PG8_LDB(B1, 1, 1); PG8_STAGE(PG8_SB(1, 0), b3, voffB);
            PG8_BAR; PG8_WAIT_L(0); PG8_MMA(0, 1, At, B1); PG8_BAR;
            PG8_LDA(At, 1, 1); PG8_STAGE(PG8_SA(1, 0), a3, voffA);
            PG8_BAR; PG8_WAIT_L(0); PG8_MMA(1, 0, At, B0); PG8_BAR; PG8_SCHED;
            PG8_STAGE(PG8_SB(1, 1), b3 + hstep, voffB);
            PG8_WAIT_V(6); PG8_BAR; PG8_MMA(1, 1, At, B1); PG8_BAR;
            }
        }
        if constexpr (ALIGN_EPI) { if (wr == 0) PG8_BAR; }
        if constexpr (!Epi::AFTER_DRAIN) { E(acc, cur, wr, wc, fr, fq); S.done(cur); }
        if (!has_next) break;
#pragma unroll
        for (int a = 0; a < 2; ++a)
#pragma unroll
            for (int b = 0; b < 2; ++b)
#pragma unroll
                for (int m = 0; m < 4; ++m)
#pragma unroll
                    for (int n = 0; n < 2; ++n) acc[a][b][m][n] = (f32x4){0.f, 0.f, 0.f, 0.f};
        cur = nxt; cA = nA; cB = nB; ++ui;
        if constexpr (ALIGN_EPI) { if (wr == 1) PG8_BAR; }
    }
    PG8_WAIT_V(0);
    if constexpr (!ALIGN_EPI) { if (wr == 0) PG8_BAR; }
    PG8_BAR;
    if constexpr (Epi::AFTER_DRAIN) { E.fused(acc, cur, wr, wc, fr, fq, lds, wid, lane); S.done(cur); }
#undef PG8_SA
#undef PG8_SB
#undef PG8_STAGE
#undef PG8_LDA
#undef PG8_LDB
#undef PG8_MMA
#undef PG8_WAIT_V
#undef PG8_WAIT_L
#undef PG8_BAR
#undef PG8_SCHED
}
}

namespace att {
typedef unsigned short bf16;
typedef short bf16x8 __attribute__((ext_vector_type(8)));
typedef short s16x4 __attribute__((ext_vector_type(4)));
typedef float f32x16 __attribute__((ext_vector_type(16)));
typedef float f32x4 __attribute__((ext_vector_type(4)));
typedef unsigned u32x4 __attribute__((ext_vector_type(4)));
constexpr int NW = 8, QBLK = 32, KVBLK = 64, QB = NW * QBLK, DV = 128;
constexpr int SHM_V = KVBLK * DV * 2, SHM_K = KVBLK * 128 * 2;
constexpr int OFF_WS = 2 * SHM_V + 2 * SHM_K, OFF_BIAS = OFF_WS + NW * 64 * 4, LDS_BYTES = OFF_BIAS + 2 * 64 * 4;
constexpr float THR = 8.f;
#define SBAR() __builtin_amdgcn_sched_barrier(0)
template <int DQK> __device__ __forceinline__ int kswz(int row, int colB) { return row * (DQK * 2) + (colB ^ (((DQK == 64 ? (row >> 1) : row) & 7) << 4)); }
__device__ __forceinline__ int v_st(int k, int c) { const int kk = (k & ~0xC) | ((k & 4) << 1) | ((k & 8) >> 1); return ((kk >> 3) * 4 + (c >> 5)) * 512 + ((kk & 7) * 32 + (c & 31)) * 2; }
__device__ __forceinline__ int v_rd_base(int lane) { return ((lane & 3) << 3) | (((lane >> 2) & 3) << 6) | (((lane >> 4) & 1) << 5) | (((lane >> 5) & 1) << 8); }
constexpr int v_rd_off(int d0, int ks, int half) { return d0 * 512 + ks * 4096 + half * 2048; }
template <int CTRL> __device__ __forceinline__ float dppf(float v) { return __int_as_float(__builtin_amdgcn_update_dpp(0, __float_as_int(v), CTRL, 0xf, 0xf, false)); }
__device__ __forceinline__ float row16_sum(float s) { s += dppf<0x128>(s); s += dppf<0x124>(s); s += dppf<0x122>(s); s += dppf<0x121>(s); return s; }
__device__ __forceinline__ float xor1(float v) { return dppf<0xB1>(v); }
__device__ __forceinline__ int crow(int r, int hi) { return (r & 3) + 8 * (r >> 2) + 4 * hi; }
__device__ __forceinline__ unsigned cvtpk(float lo, float hi) { unsigned r; asm volatile("v_cvt_pk_bf16_f32 %0, %1, %2" : "=v"(r) : "v"(lo), "v"(hi)); return r; }
__device__ __forceinline__ void mask_tile(f32x16& p0, f32x16& p1, int dq) {
    const float NEG = -__builtin_inff();
#pragma unroll
    for (int r = 0; r < 16; ++r) {
        const int c = (r & 3) + 8 * (r >> 2);
        if (dq - c < 0) p0[r] = NEG;
        if (dq - c - 32 < 0) p1[r] = NEG;
    }
}
template <int DQK>
__device__ __forceinline__ void partialSM(f32x16& p0, f32x16& p1, float& m_reg, float& mn, float& alpha) {
    constexpr float SCALE = DQK == 128 ? 0.08838834764831845f : 0.125f;
    float pmax = p0[0];
#pragma unroll
    for (int r = 1; r < 16; ++r) pmax = fmaxf(pmax, p0[r]);
#pragma unroll
    for (int r = 0; r < 16; ++r) pmax = fmaxf(pmax, p1[r]);
    { auto rr = __builtin_amdgcn_permlane32_swap(__float_as_uint(pmax), __float_as_uint(pmax), false, false);
      pmax = fmaxf(__uint_as_float(rr[0]), __uint_as_float(rr[1])); }
    constexpr float C2 = 1.4426950408889634f * SCALE;
    if (__builtin_expect(__all((pmax - m_reg) * SCALE <= THR), 1)) { mn = m_reg; alpha = 1.f; }
    else { mn = fmaxf(m_reg, pmax); alpha = __builtin_amdgcn_exp2f((m_reg - mn) * C2); m_reg = mn; }
    const float mnL = -mn * C2;
#pragma unroll
    for (int r = 0; r < 16; ++r) p0[r] = fmaf(p0[r], C2, mnL);
#pragma unroll
    for (int r = 0; r < 16; ++r) p1[r] = fmaf(p1[r], C2, mnL);
#pragma unroll
    for (int r = 0; r < 16; ++r) p0[r] = __builtin_amdgcn_exp2f(p0[r]);
}
__device__ __forceinline__ void finishSM(f32x16& p0, f32x16& p1, float alpha, float& l_reg, bf16x8& pa0, bf16x8& pa1, bf16x8& pa2, bf16x8& pa3) {
#pragma unroll
    for (int r = 0; r < 16; ++r) p1[r] = __builtin_amdgcn_exp2f(p1[r]);
    float ps = 0;
#pragma unroll
    for (int r = 0; r < 16; ++r) ps += p0[r];
#pragma unroll
    for (int r = 0; r < 16; ++r) ps += p1[r];
    { auto rr = __builtin_amdgcn_permlane32_swap(__float_as_uint(ps), __float_as_uint(ps), false, false);
      ps = __uint_as_float(rr[0]) + __uint_as_float(rr[1]); }
    l_reg = l_reg * alpha + ps;
#define PK4(P, B_, OUT) do { unsigned a0 = cvtpk(P[B_+0], P[B_+1]), a1 = cvtpk(P[B_+2], P[B_+3]);                          \
        unsigned b0 = cvtpk(P[B_+4], P[B_+5]), b1 = cvtpk(P[B_+6], P[B_+7]);                                             \
        auto r0 = __builtin_amdgcn_permlane32_swap(a0, b0, false, false); auto r1 = __builtin_amdgcn_permlane32_swap(a1, b1, false, false); \
        u32x4 w = {r0[0], r1[0], r0[1], r1[1]}; OUT = *reinterpret_cast<bf16x8*>(&w); } while (0)
    PK4(p0, 0, pa0); PK4(p0, 8, pa1); PK4(p1, 0, pa2); PK4(p1, 8, pa3);
#undef PK4
}
template <int KB, int DQK, bool BIAS>
__device__ __forceinline__ void qkt(f32x16& p0, f32x16& p1, const char* K_lds, const char* B_lds, int r32, int hi, const bf16x8* qr) {
    if constexpr (BIAS) {
        const f32x4* bp = reinterpret_cast<const f32x4*>(B_lds + KB * 256 + hi * 16);
#pragma unroll
        for (int g = 0; g < 4; ++g) { const f32x4 a = bp[2 * g], b = bp[2 * g + 8];
            p0[4 * g] = a[0]; p0[4 * g + 1] = a[1]; p0[4 * g + 2] = a[2]; p0[4 * g + 3] = a[3];
            p1[4 * g] = b[0]; p1[4 * g + 1] = b[1]; p1[4 * g + 2] = b[2]; p1[4 * g + 3] = b[3]; }
    } else { p0 = f32x16{}; p1 = f32x16{}; }
    constexpr int NK = DQK / 16, NB = NK < 4 ? NK : 4;
    const char* kb[NB];
#pragma unroll
    for (int dd = 0; dd < NB; ++dd) kb[dd] = K_lds + KB * SHM_K + kswz<DQK>(r32, (dd * 16 + hi * 8) * 2);
#pragma unroll
    for (int d0 = 0; d0 < NK; ++d0) { const char* a = kb[d0 & 3] + (d0 >> 2) * 128;
        bf16x8 b0 = *reinterpret_cast<const bf16x8*>(a);
        bf16x8 b1 = *reinterpret_cast<const bf16x8*>(a + 32 * DQK * 2);
        p0 = __builtin_amdgcn_mfma_f32_32x32x16_bf16(b0, qr[d0], p0, 0, 0, 0);
        p1 = __builtin_amdgcn_mfma_f32_32x32x16_bf16(b1, qr[d0], p1, 0, 0, 0); }
}
template <int VB>
__device__ __forceinline__ void pv_tile(f32x16* o, int vb0, bf16x8 pa0, bf16x8 pa1, bf16x8 pa2, bf16x8 pa3) {
#define TRRD(dst, off) asm volatile("ds_read_b64_tr_b16 %0, %1 offset:%2" : "=&v"(dst) : "v"(vb0), "i"(off) : "memory")
#define PV_KS(ks, PA) do { s16x4 l0, l1, l2, l3, h0, h1, h2, h3; constexpr int b_ = VB * SHM_V + v_rd_off(0, ks, 0); \
        TRRD(l0, b_); TRRD(h0, b_ + 2048); TRRD(l1, b_ + 512); TRRD(h1, b_ + 512 + 2048); TRRD(l2, b_ + 1024); TRRD(h2, b_ + 1024 + 2048); TRRD(l3, b_ + 1536); TRRD(h3, b_ + 1536 + 2048); \
        asm volatile("s_waitcnt lgkmcnt(0)" ::: "memory"); SBAR();   \
        o[0] = __builtin_amdgcn_mfma_f32_32x32x16_bf16(PA, (bf16x8){l0[0], l0[1], l0[2], l0[3], h0[0], h0[1], h0[2], h0[3]}, o[0], 0, 0, 0);   \
        o[1] = __builtin_amdgcn_mfma_f32_32x32x16_bf16(PA, (bf16x8){l1[0], l1[1], l1[2], l1[3], h1[0], h1[1], h1[2], h1[3]}, o[1], 0, 0, 0);   \
        o[2] = __builtin_amdgcn_mfma_f32_32x32x16_bf16(PA, (bf16x8){l2[0], l2[1], l2[2], l2[3], h2[0], h2[1], h2[2], h2[3]}, o[2], 0, 0, 0);   \
        o[3] = __builtin_amdgcn_mfma_f32_32x32x16_bf16(PA, (bf16x8){l3[0], l3[1], l3[2], l3[3], h3[0], h3[1], h3[2], h3[3]}, o[3], 0, 0, 0); } while (0)
    PV_KS(0, pa0); PV_KS(1, pa1); PV_KS(2, pa2); PV_KS(3, pa3);
#undef PV_KS
#undef TRRD
}

template <int VB, int DQK>
__device__ __forceinline__ void pv_sm(f32x16* o, int vb0, bf16x8 pa0, bf16x8 pa1, bf16x8 pa2, bf16x8 pa3, f32x16& p0, f32x16& p1, float& m_reg, float& mn, float& alpha) {
    constexpr float SCALE = DQK == 128 ? 0.08838834764831845f : 0.125f;
    constexpr float C2 = 1.4426950408889634f * SCALE;
#define TRRD(dst, off) asm volatile("ds_read_b64_tr_b16 %0, %1 offset:%2" : "=&v"(dst) : "v"(vb0), "i"(off) : "memory")
#define PV_LD(ks, S) do { constexpr int b_ = VB * SHM_V + v_rd_off(0, ks, 0); \
        TRRD(S##l0, b_); TRRD(S##h0, b_ + 2048); TRRD(S##l1, b_ + 512); TRRD(S##h1, b_ + 512 + 2048); TRRD(S##l2, b_ + 1024); TRRD(S##h2, b_ + 1024 + 2048); TRRD(S##l3, b_ + 1536); TRRD(S##h3, b_ + 1536 + 2048); } while (0)
#define PV_WAIT() do { asm volatile("s_waitcnt lgkmcnt(0)" ::: "memory"); SBAR(); } while (0)
#define MM(ks, S, j, PA) do { o[j] = __builtin_amdgcn_mfma_f32_32x32x16_bf16(PA, (bf16x8){S##l##j[0], S##l##j[1], S##l##j[2], S##l##j[3], S##h##j[0], S##h##j[1], S##h##j[2], S##h##j[3]}, o[j], 0, 0, 0); SBAR(); } while (0)
#define VMX(P, i) do { pm = fmaxf(fmaxf(pm, P[i]), P[(i) + 1]); pm = fmaxf(fmaxf(pm, P[(i) + 2]), P[(i) + 3]); SBAR(); } while (0)
#define VFE(k) do { float a_ = __builtin_amdgcn_exp2f(fmaf(p0[2 * (k)], C2, mnL)), b_ = __builtin_amdgcn_exp2f(fmaf(p0[2 * (k) + 1], C2, mnL)), c_ = fmaf(p1[2 * (k)], C2, mnL), d_ = fmaf(p1[2 * (k) + 1], C2, mnL); \
        asm volatile("" : "+v"(a_), "+v"(b_), "+v"(c_), "+v"(d_));     \
        p0[2 * (k)] = a_; p0[2 * (k) + 1] = b_; p1[2 * (k)] = c_; p1[2 * (k) + 1] = d_; SBAR(); } while (0)
    s16x4 Al0, Al1, Al2, Al3, Ah0, Ah1, Ah2, Ah3, Bl0, Bl1, Bl2, Bl3, Bh0, Bh1, Bh2, Bh3;
    PV_LD(0, A); PV_WAIT(); PV_LD(1, B);
    float pm = fmaxf(p0[0], p0[1]);
    MM(0, A, 0, pa0); pm = fmaxf(fmaxf(pm, p0[2]), p0[3]); SBAR();
    MM(0, A, 1, pa0); VMX(p0, 4);
    MM(0, A, 2, pa0); VMX(p0, 8);
    MM(0, A, 3, pa0); VMX(p0, 12);
    PV_WAIT(); PV_LD(2, A);
    MM(1, B, 0, pa1); VMX(p1, 0);
    MM(1, B, 1, pa1); VMX(p1, 4);
    MM(1, B, 2, pa1); VMX(p1, 8);
    MM(1, B, 3, pa1); VMX(p1, 12);
    { auto rr = __builtin_amdgcn_permlane32_swap(__float_as_uint(pm), __float_as_uint(pm), false, false);
      pm = fmaxf(__uint_as_float(rr[0]), __uint_as_float(rr[1])); }
    const bool keep = __all((pm - m_reg) * SCALE <= THR);
    mn = keep ? m_reg : fmaxf(m_reg, pm);
    alpha = __builtin_amdgcn_exp2f((m_reg - mn) * C2);
    m_reg = mn;
    const float mnL = -mn * C2;
    SBAR();
    PV_WAIT(); PV_LD(3, B);
    MM(2, A, 0, pa2); VFE(0);
    MM(2, A, 1, pa2); VFE(1);
    MM(2, A, 2, pa2); VFE(2);
    MM(2, A, 3, pa2); VFE(3);
    PV_WAIT();
    MM(3, B, 0, pa3); VFE(4);
    MM(3, B, 1, pa3); VFE(5);
    MM(3, B, 2, pa3); VFE(6);
    MM(3, B, 3, pa3); VFE(7);
#undef VFE
#undef VMX
#undef MM
#undef PV_WAIT
#undef PV_LD
#undef TRRD
}

__device__ __forceinline__ int fox_jlo(const float* Fb, int P0, float thr, int lane) {
    const int ntile = P0 >> 6;
    const float fe = Fb[64 * (lane < ntile ? lane : 0) + 63], f0 = Fb[P0];
    const bool skip = (lane < ntile) && ((f0 - fe) > thr);
    const unsigned long long mk = __ballot(skip);
    return __builtin_amdgcn_readfirstlane((int)__builtin_ctzll(~mk));
}
template <class TOut> struct BlockRef { const bf16* Q; const bf16* K; const bf16* V; const float* Fb; TOut* O; bf16* MX; int P0; int comp; };
template <int DQK> struct Seam { bf16x8 qr[DQK / 16]; bf16x8 st_v0, st_v1, st_k0, st_k1; float st_b; };

#define VMW() asm volatile("s_waitcnt vmcnt(0)" ::: "memory")
#define VMWN(n) asm volatile("s_waitcnt vmcnt(%0)" :: "i"(n) : "memory")
#define A_SLOAD(Kp, Vp, Fp, k0) do { const char* vb_ = (const char*)(Vp) + (size_t)(k0) * (DV * 2); const char* kb_ = (const char*)(Kp) + (size_t)(k0) * (DQK * 2); \
        S.st_v0 = *(const bf16x8*)(vb_ + voff); S.st_v1 = *(const bf16x8*)(vb_ + 32 * DV * 2 + voff); \
        if constexpr (DQK == 128) { S.st_k0 = *(const bf16x8*)(kb_ + voff); S.st_k1 = *(const bf16x8*)(kb_ + 32 * 256 + voff); } \
        else { S.st_k0 = *(const bf16x8*)(kb_ + koff64); } \
        if constexpr (BIAS) { S.st_b = *(const float*)((const char*)((Fp) + (k0)) + boff); } } while (0)
#define A_SWRITE_K(bf) do { if constexpr (DQK == 128) { *(bf16x8*)(K_lds + (bf) * SHM_K + kws) = S.st_k0; *(bf16x8*)(K_lds + (bf) * SHM_K + kws + 32 * 256) = S.st_k1; } \
        else { *(bf16x8*)(K_lds + (bf) * SHM_K + kws) = S.st_k0; } \
        if constexpr (BIAS) { if (wid == 0) *(float*)(B_lds + (bf) * 256 + lane * 4) = S.st_b; } } while (0)
#define A_SWRITE_V(bf) do { *(bf16x8*)(V_lds + (bf) * SHM_V + vst0) = S.st_v0; *(bf16x8*)(V_lds + (bf) * SHM_V + vst1) = S.st_v1; } while (0)
#define A_SWRITE(bf) do { A_SWRITE_V(bf); A_SWRITE_K(bf); } while (0)
#define A_GEOM() const int tid = ltid(), wid = __builtin_amdgcn_readfirstlane(tid >> 6), lane = tid & 63, r32 = lane & 31, hi = lane >> 5; \
    const int sr = tid >> 4, sc = (tid & 15) * 8, kr64 = tid >> 3, kc64 = (tid & 7) * 8; \
    const int kws = DQK == 128 ? kswz<128>(sr, sc * 2) : kswz<64>(kr64, kc64 * 2); \
    const unsigned voff = (unsigned)(sr * DV + sc) * 2u, koff64 = (unsigned)(kr64 * 64 + kc64) * 2u, boff = (unsigned)lane * 4u; (void)voff; (void)koff64; (void)boff; \
    char* V_lds = lds; char* K_lds = lds + 2 * SHM_V; char* B_lds = lds + OFF_BIAS; (void)V_lds; (void)B_lds; (void)r32; (void)hi; (void)kr64; (void)kc64; (void)sr; (void)sc

template <int DQK, bool BIAS, class TOut>
__device__ __forceinline__ void causal_prime(const BlockRef<TOut>& cur, int jlo, char* lds, Seam<DQK>& S) {
    A_GEOM();
#pragma unroll
    for (int d0 = 0; d0 < DQK / 16; ++d0) S.qr[d0] = *(const bf16x8*)(cur.Q + (size_t)(wid * QBLK + r32) * DQK + d0 * 16 + hi * 8);
    A_SLOAD(cur.K, cur.V, cur.Fb, jlo * KVBLK); VMW(); A_SWRITE_K(0);
    __syncthreads();
}
template <int DQK, bool BIAS, class TOut, int OST, class RF>
__device__ __forceinline__ void causal_block(const RF& rf, int Lc, int pc, int Ln, int pn, char* lds, Seam<DQK>& S) {
    A_GEOM();
    const BlockRef<TOut> cur = rf(Lc, pc);
    int jlo = 0; if constexpr (BIAS) jlo = rf.jlo_of(pc);
    const int NT = (cur.P0 + QB - 1) / KVBLK + 1 - jlo;
    const int qlo = cur.P0 + wid * QBLK, qm = qlo + r32 - 4 * hi;
    float* ws = (float*)(lds + OFF_WS) + wid * 64; float* li_l = ws, * al_l = ws + 32;
    float m_reg = -1e30f, l_reg = 0; f32x16 o[4] = {};
    const int vst0 = v_st(sr, sc), vst1 = v_st(32 + sr, sc);
    const int vb0 = (int)(uintptr_t)V_lds + v_rd_base(lane);
    const bf16* Kh = cur.K; const bf16* Vh = cur.V; const float* Fh = cur.Fb;
#define RESC(a) do { if (__any((a) < 1.f)) { if (hi == 0) al_l[r32] = (a); asm volatile("s_waitcnt lgkmcnt(0)" ::: "memory");              \
                     for (int d_ = 0; d_ < 4; ++d_) for (int r = 0; r < 16; ++r) o[d_][r] *= al_l[crow(r, hi)]; } } while (0)
#define KBASE(t) ((jlo + (t)) * KVBLK)
#define MASKT(P0_, P1_, t) do { const int kb_ = KBASE(t); if (kb_ + KVBLK - 1 > qlo) mask_tile(P0_, P1_, qm - kb_); } while (0)
    constexpr int NQL = DQK / 16;
    f32x16 pA0, pA1, pB0, pB1; float mnA, mnB, alA, alB; bf16x8 pa0, pa1, pa2, pa3;
    A_SWRITE_V(0); SBAR();
    if (NT > 1) { A_SLOAD(Kh, Vh, Fh, KBASE(1)); }
    SBAR(); qkt<0, DQK, BIAS>(pA0, pA1, K_lds, B_lds, r32, hi, S.qr);
    MASKT(pA0, pA1, 0); partialSM<DQK>(pA0, pA1, m_reg, mnA, alA);
    if (NT > 1) { VMW(); A_SWRITE(1); }
    __syncthreads();
#define HALF_STEP(PX0, PX1, mnX, alX, PY0, PY1, alY, t, KB, VB, SB) do {                                                      \
        SBAR(); qkt<KB, DQK, BIAS>(PX0, PX1, K_lds, B_lds, r32, hi, S.qr);                                                    \
        finishSM(PY0, PY1, alY, l_reg, pa0, pa1, pa2, pa3); SBAR();                                                           \
        if ((t) + 1 < NT) { A_SLOAD(Kh, Vh, Fh, KBASE((t) + 1)); SBAR(); }                                                    \
        if constexpr (BIAS) { pv_tile<VB>(o, vb0, pa0, pa1, pa2, pa3); MASKT(PX0, PX1, (t)); partialSM<DQK>(PX0, PX1, m_reg, mnX, alX); } \
        else { MASKT(PX0, PX1, (t)); SBAR(); pv_sm<VB, DQK>(o, vb0, pa0, pa1, pa2, pa3, PX0, PX1, m_reg, mnX, alX); }         \
        __syncthreads();                                                                                                      \
        if ((t) + 1 < NT) { VMW(); A_SWRITE(SB); }                                                                            \
        RESC(alX); __syncthreads(); } while (0)
    for (int t = 1; t + 1 < NT; t += 2) {
        HALF_STEP(pB0, pB1, mnB, alB, pA0, pA1, alA, t, 1, 0, 0);
        HALF_STEP(pA0, pA1, mnA, alA, pB0, pB1, alB, t + 1, 0, 1, 1);
    }
    const bool even = (NT & 1) == 0;
    if (even) { SBAR(); qkt<1, DQK, BIAS>(pB0, pB1, K_lds, B_lds, r32, hi, S.qr); SBAR(); }
    { const BlockRef<TOut> nxt = rf(Ln, pn);
    int jn = 0; if constexpr (BIAS) jn = rf.jlo_of(pn);
    A_SLOAD(nxt.K, nxt.V, nxt.Fb, jn * KVBLK); SBAR();
#pragma unroll
    for (int d0 = 0; d0 < DQK / 16; ++d0) S.qr[d0] = *(const bf16x8*)(nxt.Q + (size_t)(wid * QBLK + r32) * DQK + d0 * 16 + hi * 8);
    }
    SBAR();
    finishSM(pA0, pA1, alA, l_reg, pa0, pa1, pa2, pa3); SBAR();
    pv_tile<0>(o, vb0, pa0, pa1, pa2, pa3);
    if (even) { MASKT(pB0, pB1, NT - 1); partialSM<DQK>(pB0, pB1, m_reg, mnB, alB); __syncthreads(); RESC(alB);
        finishSM(pB0, pB1, alB, l_reg, pa0, pa1, pa2, pa3); SBAR(); pv_tile<1>(o, vb0, pa0, pa1, pa2, pa3); }
    SBAR(); VMWN(NQL); A_SWRITE_K(0); SBAR();
    if (hi == 0) li_l[r32] = l_reg; asm volatile("s_waitcnt lgkmcnt(0)" ::: "memory");
    float rli[16];
#pragma unroll
    for (int r = 0; r < 16; ++r) rli[r] = __builtin_amdgcn_rcpf(li_l[crow(r, hi)]);
    { const BlockRef<TOut> ce = rf(Lc, pc);
    TOut* Ow = ce.O + (size_t)(wid * QBLK) * OST;
    if constexpr (sizeof(TOut) == 4) {
        if (ce.comp == 0) {
            f32x4* Ox = (f32x4*)Ow + lane;
#pragma unroll
            for (int d0 = 0; d0 < 4; ++d0)
#pragma unroll
                for (int q = 0; q < 4; ++q) Ox[(d0 * 4 + q) * 64] = (f32x4){o[d0][4 * q] * rli[4 * q], o[d0][4 * q + 1] * rli[4 * q + 1], o[d0][4 * q + 2] * rli[4 * q + 2], o[d0][4 * q + 3] * rli[4 * q + 3]};
        } else {
            bf16* Mw = ce.MX + (size_t)(wid * QBLK) * 2048;
            float gs[4];
#pragma unroll
            for (int d0 = 0; d0 < 4; ++d0) gs[d0] = rf.gsub[d0 * 32 + r32] * rf.gmul;
            const float lam = rf.lam;
            f32x16 o1[4];
            { const f32x4* Ox = (const f32x4*)Ow + lane;
#pragma unroll
              for (int d0 = 0; d0 < 4; ++d0)
#pragma unroll
                  for (int q = 0; q < 4; ++q) { const f32x4 t = Ox[(d0 * 4 + q) * 64]; o1[d0][4 * q] = t[0]; o1[d0][4 * q + 1] = t[1]; o1[d0][4 * q + 2] = t[2]; o1[d0][4 * q + 3] = t[3]; } }
            SBAR();
#pragma unroll
            for (int r = 0; r < 16; ++r) { const int orow = crow(r, hi); float e[4], ss = 0.f;
#pragma unroll
                for (int d0 = 0; d0 < 4; ++d0) { e[d0] = o1[d0][r] - lam * (o[d0][r] * rli[r]); ss += e[d0] * e[d0]; }
                ss = row16_sum(ss); { auto rr = __builtin_amdgcn_permlane16_swap(__float_as_uint(ss), __float_as_uint(ss), false, false); ss = __uint_as_float(rr[0]) + __uint_as_float(rr[1]); }
                const float rinv = 1.f / sqrtf(ss * (1.f / 128.f) + 1e-5f);
#pragma unroll
                for (int p = 0; p < 2; ++p) {
                    const float a_ = e[2 * p] * rinv * gs[2 * p], b_ = e[2 * p + 1] * rinv * gs[2 * p + 1];
                    const bool ev = (r32 & 1) == 0; const float x_ = xor1(ev ? b_ : a_);
                    *(unsigned*)(Mw + (size_t)orow * 2048 + (ev ? (2 * p) * 32 + r32 : (2 * p + 1) * 32 + r32 - 1)) = cvtpk(ev ? a_ : x_, ev ? x_ : b_); } }
        }
    } else {
#pragma unroll
        for (int r = 0; r < 16; ++r) { const int orow = crow(r, hi);
#pragma unroll
            for (int p = 0; p < 2; ++p) {
                const float a_ = o[2 * p][r] * rli[r], b_ = o[2 * p + 1][r] * rli[r];
                const bool ev = (r32 & 1) == 0; const float x_ = xor1(ev ? b_ : a_);
                *(unsigned*)(Ow + (size_t)orow * OST + (ev ? (2 * p) * 32 + r32 : (2 * p + 1) * 32 + r32 - 1)) = cvtpk(ev ? a_ : x_, ev ? x_ : b_); } }
    } }
    __syncthreads();
#undef RESC
#undef KBASE
#undef MASKT
#undef HALF_STEP
}
#undef VMW
#undef VMWN
#undef A_SLOAD
#undef A_SWRITE_K
#undef A_SWRITE_V
#undef A_SWRITE
#undef A_GEOM
}
#define LAS __attribute__((address_space(3)))
#define XB_TMO      128
#define XB_XCNT(j)  (256  + 64 * (j))
#define XB_XSUB(j)  (1280 + 64 * (j))
#define XB_XGEN(j)  (2304 + 64 * (j))
#define XB_TOP      3328
#define XB_TOPGEN   3392
#define XCD_BAR_WORDS 3456
#define XB_SPIN_CAP (1u << 18)

__device__ __forceinline__ unsigned xb_ld(unsigned* p)              { return __hip_atomic_load(p, __ATOMIC_RELAXED, __HIP_MEMORY_SCOPE_AGENT); }
__device__ __forceinline__ unsigned xb_add(unsigned* p, unsigned v) { return __hip_atomic_fetch_add(p, v, __ATOMIC_RELAXED, __HIP_MEMORY_SCOPE_AGENT); }
__device__ __forceinline__ unsigned xb_xcc_id() { return (unsigned)__builtin_amdgcn_s_getreg((3 << 11) | 20) & 0xFu; }
#define XB_SPIN(cond, bar) do { unsigned _sp = 0; while (cond) { __builtin_amdgcn_s_sleep(1); \
    if ((++_sp & 255u) == 0u) { if (xb_ld(&(bar)[XB_TMO])) break; if (_sp > XB_SPIN_CAP) { atomicAdd(&(bar)[XB_TMO], 1u); break; } } } } while (0)

struct XcdBarrier {
    unsigned* bar; unsigned x;
    volatile LAS unsigned* st;
};

__device__ __forceinline__ XcdBarrier xcd_barrier_post(unsigned* bar, volatile LAS unsigned* st) {
    XcdBarrier b; b.bar = bar; b.x = xb_xcc_id(); b.st = st;
    if (threadIdx.x == 0) (void)xb_add(&bar[XB_XCNT(b.x)], 1u);
    return b;
}
__device__ __forceinline__ void xcd_barrier_complete(unsigned* bar, unsigned x, unsigned& nloc, unsigned& nx) {
    const unsigned G = gridDim.x * gridDim.y * gridDim.z;
    unsigned sum, cnt, mine, sp = 0u;
    for (;;) {
        sum = 0u; cnt = 0u; mine = 0u;
#pragma unroll
        for (unsigned j = 0; j < 16; ++j) { const unsigned c = xb_ld(&bar[XB_XCNT(j)]); sum += c; cnt += (c > 0u) ? 1u : 0u; mine = (j == x) ? c : mine; }
        if (sum == G) break;
        __builtin_amdgcn_s_sleep(1);
        if ((++sp & 255u) == 0u) { if (xb_ld(&bar[XB_TMO])) break; if (sp > XB_SPIN_CAP) { atomicAdd(&bar[XB_TMO], 1u); break; } }
    }
    nloc = mine > 0u ? mine : 1u; nx = cnt > 0u ? cnt : 1u;
}

__device__ __forceinline__ void xcd_barrier(const XcdBarrier& b) {
    asm volatile("s_waitcnt vmcnt(0)" ::: "memory");
    __syncthreads();
    if (threadIdx.x == 0) {
        unsigned* bar = b.bar;
        __builtin_amdgcn_s_waitcnt(0);
        unsigned nloc = b.st[0], nx = b.st[1];
        if (nloc == 0u) { xcd_barrier_complete(bar, b.x, nloc, nx); b.st[0] = nloc; b.st[1] = nx; }
        const unsigned old = xb_add(&bar[XB_XSUB(b.x)], 1u);
        const unsigned gen = old / nloc;
        if (old + 1u == (gen + 1u) * nloc) {
            __builtin_amdgcn_fence(__ATOMIC_RELEASE, "agent");
            asm volatile("s_waitcnt vmcnt(0)" ::: "memory");
            const unsigned og = xb_add(&bar[XB_TOP], 1u);
            const unsigned tg = og / nx;
            if (og + 1u == (tg + 1u) * nx) xb_add(&bar[XB_TOPGEN], 1u);
            else XB_SPIN(xb_ld(&bar[XB_TOPGEN]) == tg, bar);
            __builtin_amdgcn_fence(__ATOMIC_ACQUIRE, "agent");
            xb_add(&bar[XB_XGEN(b.x)], 1u);
            asm volatile("s_waitcnt vmcnt(0)" ::: "memory");
        } else {
            XB_SPIN(xb_ld(&bar[XB_XGEN(b.x)]) == gen, bar);
            __builtin_amdgcn_fence(__ATOMIC_ACQUIRE, "agent");
            asm volatile("s_waitcnt vmcnt(0)" ::: "memory");
        }
    }
    __syncthreads();
}

constexpr int BATCH = 4, SEQ = 4096, DM = 2048, DEPTH = 2, NFOX = 8, NDIFF = 8, HD = 128, DFF = 8192, INCOLS = 6152, NQKV = 6144;
constexpr int M = BATCH * SEQ;
constexpr float LN_EPS = 1e-5f, RMS_EPS = 1e-5f, ALPHA = 1.4142135623730951f;
constexpr float FOX_INV_SCALE = 11.313708498984761f;
constexpr int NWAVES = 8, NTHREADS = 512;
constexpr int LDS_BYTES = 147456;

constexpr size_t MiB = 1u << 20;
constexpr size_t WS_MOD = 0;
constexpr size_t WS_BAR = 512 * 1024;
constexpr size_t WS_ROPE = 1 * MiB;
constexpr size_t WS_LF = 2 * MiB;
constexpr size_t WS_FB = 3 * MiB;
constexpr size_t WS_WIN = 4 * MiB;
constexpr size_t WS_WO = 28 * MiB;
constexpr size_t WS_WUP = 36 * MiB;
constexpr size_t WS_WDN = 68 * MiB;
constexpr size_t WS_H = 100 * MiB;
constexpr size_t WS_QKV = 164 * MiB;
constexpr size_t WS_MIX = 356 * MiB;
constexpr size_t WS_U = 164 * MiB;
constexpr size_t WS_Z = 420 * MiB;
constexpr size_t WS_OD = 420 * MiB;
constexpr size_t WS_XA = 548 * MiB;
constexpr size_t WS_X2 = 612 * MiB;
constexpr size_t WS_END = 676 * MiB;

typedef unsigned short bf16;
typedef float f32x4 __attribute__((ext_vector_type(4)));
typedef unsigned u32x4 __attribute__((ext_vector_type(4)));
typedef unsigned u32x2 __attribute__((ext_vector_type(2)));
#ifndef LAS
#define LAS __attribute__((address_space(3)))
#endif

#include <type_traits>
struct Params {
    const float* x; const float* c; const int* pos; const float* w_ada; const float* b_ada; const float* w_in; const float* b_f;
    const float* lq1; const float* lk1; const float* lq2; const float* lk2; const float* subln_g; const float* w_o;
    const float* ln1_g; const float* ln1_b; const float* w_up; const float* w_down; const float* ln2_g; const float* ln2_b;
    float* out; unsigned char* ws;
};

__device__ __forceinline__ unsigned f2bf(float f) { unsigned u = __builtin_bit_cast(unsigned, f); return (u + 0x7fffu + ((u >> 16) & 1u)) >> 16; }
__device__ __forceinline__ unsigned pk2(float lo, float hi) { return f2bf(lo) | (f2bf(hi) << 16); }
__device__ __forceinline__ float wave_sum(float v) {
#pragma unroll
    for (int o = 1; o < 64; o <<= 1) v += __shfl_xor(v, o);
    return v;
}
#define LDS_WAIT() asm volatile("s_waitcnt lgkmcnt(0)" ::: "memory")

struct TrItem { const float* W; bf16* WT; int K, N, ldw, col_off, row_off, item; };
__device__ __forceinline__ void tr_load(const TrItem& t, float (&tv)[32], int lane) {
    const int nblk = t.N / 32, kb = t.item / nblk, nb = t.item % nblk, k0 = 64 * kb, n0 = 32 * nb;
#pragma unroll
    for (int i = 0; i < 32; ++i) { const int kk = 2 * i + (lane >> 5); tv[i] = t.W[(size_t)(k0 + kk) * t.ldw + t.col_off + n0 + (lane & 31)]; }
    __builtin_amdgcn_sched_barrier(0);
}
__device__ __forceinline__ void tr_store(const TrItem& t, const float (&tv)[32], LAS float* scr, int lane) {
    const int nblk = t.N / 32, kb = t.item / nblk, nb = t.item % nblk, k0 = 64 * kb, n0 = 32 * nb;
#pragma unroll
    for (int i = 0; i < 32; ++i) { const int kk = 2 * i + (lane >> 5); scr[kk * 33 + (lane & 31)] = tv[i]; }
    LDS_WAIT(); asm volatile("" ::: "memory");
    const int c = lane & 7;
#pragma unroll
    for (int j = 0; j < 4; ++j) { const int n = (lane >> 3) + 8 * j; const LAS float* s = scr + (8 * c) * 33 + n;
        u32x4 o; o.x = pk2(s[0 * 33], s[1 * 33]); o.y = pk2(s[2 * 33], s[3 * 33]); o.z = pk2(s[4 * 33], s[5 * 33]); o.w = pk2(s[6 * 33], s[7 * 33]);
        *(u32x4*)(t.WT + (size_t)(t.row_off + n0 + n) * t.K + k0 + 8 * c) = o; }
    LDS_WAIT(); asm volatile("" ::: "memory");
}
__device__ __forceinline__ void convert_weights(const Params& P, int l, LAS unsigned char* lds, int gw, int NGW, int wave, int lane) {
    LAS float* scr = (LAS float*)(lds + wave * 16384);
    unsigned char* ws = P.ws;
    constexpr int I_IN = (DM / 64) * (3072 / 32), I_O = (DM / 64) * (DM / 32), I_UP = (DM / 64) * (DFF / 32), I_DN = (DFF / 64) * (DM / 32);
    constexpr int NITEMS = 2 * I_IN + I_O + I_UP + I_DN;
    const float* w_in = P.w_in + (size_t)l * DM * INCOLS; const float* w_o = P.w_o + (size_t)l * DM * DM;
    const float* w_up = P.w_up + (size_t)l * DM * DFF; const float* w_dn = P.w_down + (size_t)l * DFF * DM;
#define TR_ITEM(t_, it_) do { int r = (it_); \
        if (r < I_IN) { t_ = TrItem{w_in, (bf16*)(ws + WS_WIN), DM, 3072, INCOLS, 0, 0, r}; } \
        else if ((r -= I_IN) < I_IN) { t_ = TrItem{w_in, (bf16*)(ws + WS_WIN), DM, 3072, INCOLS, 3080, 3072, r}; } \
        else if ((r -= I_IN) < I_O) { t_ = TrItem{w_o, (bf16*)(ws + WS_WO), DM, DM, DM, 0, 0, r}; } \
        else if ((r -= I_O) < I_UP) { t_ = TrItem{w_up, (bf16*)(ws + WS_WUP), DM, DFF, DFF, 0, 0, r}; } \
        else { r -= I_UP; t_ = TrItem{w_dn, (bf16*)(ws + WS_WDN), DFF, DM, DM, 0, 0, r}; } } while (0)
    float ta[32], tb[32]; TrItem A, B;
    int it = gw;
    if (it < NITEMS) { TR_ITEM(A, it); tr_load(A, ta, lane); }
#pragma unroll 1
    for (; it < NITEMS; it += 2 * NGW) {
        const bool hb = it + NGW < NITEMS;
        if (hb) { TR_ITEM(B, it + NGW); tr_load(B, tb, lane); }
        tr_store(A, ta, scr, lane);
        if (!hb) break;
        if (it + 2 * NGW < NITEMS) { TR_ITEM(A, it + 2 * NGW); tr_load(A, ta, lane); }
        tr_store(B, tb, scr, lane);
    }
#undef TR_ITEM
}
__device__ __forceinline__ void adaln_phase(const Params& P, LAS unsigned char* lds, int tid) {
    LAS float* ca = (LAS float*)lds;
    LAS float* red = (LAS float*)(lds + 32768);
    for (int i = tid; i < BATCH * DM; i += NTHREADS) { const float v = P.c[i]; ca[i] = v / (1.f + __expf(-v)); }
    __syncthreads();
    float* mod = (float*)(P.ws + WS_MOD);
    const int kg = tid >> 5, col = tid & 31;
    constexpr int NCH = 6 * DM / 32;
    for (int it = blockIdx.x; it < DEPTH * NCH; it += gridDim.x) {
        const int l = it / NCH, n0 = (it % NCH) * 32;
        const float* w = P.w_ada + (size_t)l * DM * 6 * DM + n0 + col;
        float a0 = 0.f, a1 = 0.f, a2 = 0.f, a3 = 0.f;
        float wa[16], wb[16];
#define ADA_LD(W_, kb_) do { _Pragma("unroll") for (int i = 0; i < 16; ++i) W_[i] = w[(size_t)((kb_) + kg + 16 * i) * (6 * DM)]; __builtin_amdgcn_sched_barrier(0); } while (0)
#define ADA_FM(W_, kb_) do { _Pragma("unroll") for (int i = 0; i < 16; ++i) { const int k = (kb_) + kg + 16 * i; a0 += ca[k] * W_[i]; a1 += ca[DM + k] * W_[i]; a2 += ca[2 * DM + k] * W_[i]; a3 += ca[3 * DM + k] * W_[i]; } } while (0)
        ADA_LD(wa, 0);
#pragma unroll 1
        for (int kb = 0; kb < DM; kb += 2 * 256) {
            ADA_LD(wb, kb + 256);
            ADA_FM(wa, kb);
            if (kb + 512 < DM) ADA_LD(wa, kb + 512);
            ADA_FM(wb, kb + 256);
        }
#undef ADA_LD
#undef ADA_FM
        red[(kg * 4 + 0) * 32 + col] = a0; red[(kg * 4 + 1) * 32 + col] = a1; red[(kg * 4 + 2) * 32 + col] = a2; red[(kg * 4 + 3) * 32 + col] = a3;
        __syncthreads();
        if (tid < 128) { const int b = tid >> 5; float s = 0.f;
#pragma unroll
            for (int g = 0; g < 16; ++g) s += red[(g * 4 + b) * 32 + col];
            mod[((size_t)l * BATCH + b) * (6 * DM) + n0 + col] = s + P.b_ada[(size_t)l * 6 * DM + n0 + col]; }
        __syncthreads();
    }
}
__device__ __forceinline__ void rope_one(float* rope, int m, int i, float posf, float inv_freq) {
    const float ang = posf * inv_freq;
    const double a = (double)ang, q = __builtin_rint(a * 0.63661977236758134308);
    const double r = (a - q * 1.5707963267948966192) - q * 6.123233995736766e-17, r2 = r * r;
    const double sn = r * (1.0 + r2 * (-1.0 / 6 + r2 * (1.0 / 120 + r2 * (-1.0 / 5040 + r2 * (1.0 / 362880 + r2 * (-1.0 / 39916800 + r2 * (1.0 / 6227020800.0)))))));
    const double cs = 1.0 + r2 * (-0.5 + r2 * (1.0 / 24 + r2 * (-1.0 / 720 + r2 * (1.0 / 40320 + r2 * (-1.0 / 3628800 + r2 * (1.0 / 479001600 + r2 * (-1.0 / 87178291200.0)))))));
    const int qi = ((int)q) & 3;
    const double c = (qi == 0) ? cs : (qi == 1) ? -sn : (qi == 2) ? -cs : sn;
    const double s = (qi == 0) ? sn : (qi == 1) ? cs : (qi == 2) ? -sn : -cs;
    rope[(size_t)m * 16 + i] = (float)c; rope[(size_t)m * 16 + 8 + i] = (float)s;
}
__device__ __forceinline__ void rope_phase(const Params& P, int gtid, int gthreads) {
    float* rope = (float*)(P.ws + WS_ROPE);
    for (int m = gtid; m < M; m += gthreads) {
        const float pf = (float)P.pos[m];
        rope_one(rope, m, 0, pf, 0x1.0000000000000p+0f); rope_one(rope, m, 1, pf, 0x1.8d275e0000000p-3f); rope_one(rope, m, 2, pf, 0x1.3411900000000p-5f); rope_one(rope, m, 3, pf, 0x1.ddee9c0000000p-8f);
        rope_one(rope, m, 4, pf, 0x1.72ba440000000p-10f); rope_one(rope, m, 5, pf, 0x1.1f91f00000000p-12f); rope_one(rope, m, 6, pf, 0x1.be21880000000p-15f); rope_one(rope, m, 7, pf, 0x1.5a0f4e0000000p-17f);
    }
}
__device__ __forceinline__ float log_sigmoid(float x) { return fminf(x, 0.f) - 0.6931471805599453f * __builtin_amdgcn_logf(1.f + __builtin_amdgcn_exp2f(-1.4426950408889634f * fabsf(x))); }

__device__ __forceinline__ void stage_wf(const Params& P, int l, LAS unsigned char* lds, int tid) {
    LAS float* wf = (LAS float*)lds;
    const float* w = P.w_in + (size_t)l * DM * INCOLS + 3072;
    f32x4 a[4], b[4];
#pragma unroll
    for (int i = 0; i < 4; ++i) { const float* p = w + (size_t)(tid + NTHREADS * i) * INCOLS; a[i] = *(const f32x4*)p; b[i] = *(const f32x4*)(p + 4); }
#pragma unroll
    for (int i = 0; i < 4; ++i) { const int k = tid + NTHREADS * i;
        wf[0 * DM + k] = a[i].x; wf[1 * DM + k] = a[i].y; wf[2 * DM + k] = a[i].z; wf[3 * DM + k] = a[i].w;
        wf[4 * DM + k] = b[i].x; wf[5 * DM + k] = b[i].y; wf[6 * DM + k] = b[i].z; wf[7 * DM + k] = b[i].w; }
    __syncthreads();
}
__device__ __forceinline__ unsigned cvtpk_bf16(float lo, float hi) { unsigned r; asm volatile("v_cvt_pk_bf16_f32 %0, %1, %2" : "=v"(r) : "v"(lo), "v"(hi)); return r; }
__device__ __forceinline__ int wave_row(int gw, int NGW, int i) {
    const int wpb = NGW / BATCH;
    if (NGW % BATCH == 0 && SEQ % wpb == 0) return (gw / wpb) * SEQ + (gw % wpb) + i * wpb;
    return gw + i * NGW;
}
__device__ __forceinline__ int wave_nrows(int gw, int NGW) {
    const int wpb = NGW / BATCH;
    if (NGW % BATCH == 0 && SEQ % wpb == 0) return SEQ / wpb;
    return (M - gw + NGW - 1) / NGW;
}
template <bool GATES>
__device__ __forceinline__ void modulate_row(const Params& P, int l, int m, const f32x4 (&xv)[8], const f32x4 (&sc1)[8], const f32x4 (&sh)[8], LAS unsigned char* lds, int lane, float bfl) {
    bf16* hrow = (bf16*)(P.ws + WS_H) + (size_t)m * DM;
    float g0 = 0.f, g1 = 0.f, g2 = 0.f, g3 = 0.f, g4 = 0.f, g5 = 0.f, g6 = 0.f, g7 = 0.f;
#pragma unroll
    for (int j = 0; j < 8; ++j) {
        const int o = 256 * j + 4 * lane;
        const f32x4 h = xv[j] * sc1[j] + sh[j];
        u32x2 ov; ov.x = cvtpk_bf16(h.x, h.y); ov.y = cvtpk_bf16(h.z, h.w);
        *(u32x2*)(hrow + o) = ov;
        if constexpr (GATES) {
            const LAS float* wf = (const LAS float*)lds + o;
#define GDOT(q, acc) { const f32x4 w = *(const LAS f32x4*)(wf + (q) * DM); acc += h.x * w.x + h.y * w.y + h.z * w.z + h.w * w.w; }
            GDOT(0, g0) GDOT(1, g1) GDOT(2, g2) GDOT(3, g3) GDOT(4, g4) GDOT(5, g5) GDOT(6, g6) GDOT(7, g7)
#undef GDOT
            __builtin_amdgcn_sched_barrier(0);
        }
    }
    if constexpr (GATES) {
        const int b = m >> 12, s = m & (SEQ - 1);
        float* lf = (float*)(P.ws + WS_LF);
        { const bool up = lane & 1; const float s0 = up ? g0 : g1, s1 = up ? g2 : g3, s2 = up ? g4 : g5, s3 = up ? g6 : g7;
          const float k0 = up ? g1 : g0, k1 = up ? g3 : g2, k2 = up ? g5 : g4, k3 = up ? g7 : g6;
          g0 = k0 + __shfl_xor(s0, 1); g1 = k1 + __shfl_xor(s1, 1); g2 = k2 + __shfl_xor(s2, 1); g3 = k3 + __shfl_xor(s3, 1); }
        { const bool up = lane & 2; const float s0 = up ? g0 : g1, s1 = up ? g2 : g3; const float k0 = up ? g1 : g0, k1 = up ? g3 : g2;
          g0 = k0 + __shfl_xor(s0, 2); g1 = k1 + __shfl_xor(s1, 2); }
        { const bool up = lane & 4; const float s0 = up ? g0 : g1; const float k0 = up ? g1 : g0;
          g0 = k0 + __shfl_xor(s0, 4); }
        g0 += __shfl_xor(g0, 8); g0 += __shfl_xor(g0, 16); g0 += __shfl_xor(g0, 32);
        if (lane < 8) lf[((size_t)b * NFOX + lane) * SEQ + s] = log_sigmoid(g0 + bfl);
    }
}
__device__ __forceinline__ void modgate_phase(const Params& P, int l, const float* xin, LAS unsigned char* lds, int gw, int NGW, int lane) {
    stage_wf(P, l, lds, ltid());
    const float* mod = (const float*)(P.ws + WS_MOD) + (size_t)l * BATCH * 6 * DM;
    const int nrow = wave_nrows(gw, NGW); int bprev = -1;
    const float bfl = P.b_f[l * NFOX + (lane & 7)];
    f32x4 sc1[8], sh[8], va[8], vb[8];
#define MG_LOAD(V, i_) do { const int m_ = wave_row(gw, NGW, (i_)); _Pragma("unroll") for (int j = 0; j < 8; ++j) V[j] = *(const f32x4*)(xin + (size_t)m_ * DM + 256 * j + 4 * lane); __builtin_amdgcn_sched_barrier(0); } while (0)
#define MG_PROC(V, i_) do { const int m = wave_row(gw, NGW, (i_)), b = m >> 12; \
        if (b != bprev) { bprev = b; _Pragma("unroll") for (int j = 0; j < 8; ++j) { sh[j] = *(const f32x4*)(mod + (size_t)b * 6 * DM + 256 * j + 4 * lane); sc1[j] = *(const f32x4*)(mod + (size_t)b * 6 * DM + DM + 256 * j + 4 * lane) + 1.f; } } \
        modulate_row<true>(P, l, m, V, sc1, sh, lds, lane, bfl); } while (0)
    if (nrow > 0) MG_LOAD(va, 0);
#pragma unroll 1
    for (int i = 0; i < nrow; i += 2) {
        if (i + 1 < nrow) MG_LOAD(vb, i + 1);
        MG_PROC(va, i);
        if (i + 1 >= nrow) break;
        if (i + 2 < nrow) MG_LOAD(va, i + 2);
        MG_PROC(vb, i + 1);
    }
#undef MG_LOAD
#undef MG_PROC
}
template <bool GATES, bool MODULATE, bool XIN_BF, bool XOUT_BF>
__device__ __forceinline__ void ln_phase(const Params& P, const void* xres_, const bf16* y, const float* lng, const float* lnb, void* xo_, int lm, int shi, LAS unsigned char* lds, int gw, int NGW, int lane) {
    typedef typename std::conditional<XIN_BF, u32x2, f32x4>::type xin_t;
    { const int tid = ltid(); LAS float* gl = (LAS float*)(lds + 65536);
      *(LAS f32x4*)(gl + 4 * tid) = *(const f32x4*)(lng + 4 * tid); *(LAS f32x4*)(gl + DM + 4 * tid) = *(const f32x4*)(lnb + 4 * tid); }
    if constexpr (GATES) stage_wf(P, lm, lds, ltid()); else __syncthreads();
    const LAS float* gl = (const LAS float*)(lds + 65536);
    const float* mod = (const float*)(P.ws + WS_MOD) + (size_t)lm * BATCH * 6 * DM;
    const int nrow = wave_nrows(gw, NGW); int bprev = -1;
    float bfl = 0.f; if constexpr (GATES) bfl = P.b_f[lm * NFOX + (lane & 7)];
    f32x4 sc1[8], sh[8], xw[8]; xin_t xa[8], xb[8]; u32x2 ya[8], yb[8];
#define LN_LOAD(X, Y, i_) do { const int m_ = wave_row(gw, NGW, (i_)); _Pragma("unroll") for (int j = 0; j < 8; ++j) { const size_t o_ = (size_t)m_ * DM + 256 * j + 4 * lane; if constexpr (XIN_BF) X[j] = *(const xin_t*)((const bf16*)xres_ + o_); else X[j] = *(const xin_t*)((const float*)xres_ + o_); Y[j] = *(const u32x2*)(y + o_); } __builtin_amdgcn_sched_barrier(0); } while (0)
#define LN_PROC(XI, Y, i_) do { const int m = wave_row(gw, NGW, (i_)), b = m >> 12; float s = 0.f; f32x4 (&X)[8] = xw; \
        _Pragma("unroll") for (int j = 0; j < 8; ++j) { f32x4 xr_; \
            if constexpr (XIN_BF) { xr_.x = __uint_as_float(XI[j][0] << 16); xr_.y = __uint_as_float(XI[j][0] & 0xffff0000u); xr_.z = __uint_as_float(XI[j][1] << 16); xr_.w = __uint_as_float(XI[j][1] & 0xffff0000u); } \
            else { xr_.x = XI[j][0]; xr_.y = XI[j][1]; xr_.z = XI[j][2]; xr_.w = XI[j][3]; } \
            X[j].x = xr_.x * ALPHA + __uint_as_float(Y[j].x << 16); X[j].y = xr_.y * ALPHA + __uint_as_float(Y[j].x & 0xffff0000u); \
            X[j].z = xr_.z * ALPHA + __uint_as_float(Y[j].y << 16); X[j].w = xr_.w * ALPHA + __uint_as_float(Y[j].y & 0xffff0000u); \
            s += (X[j].x + X[j].y) + (X[j].z + X[j].w); } \
        if constexpr (MODULATE) { if (b != bprev) { bprev = b; _Pragma("unroll") for (int j = 0; j < 8; ++j) { sh[j] = *(const f32x4*)(mod + (size_t)b * 6 * DM + (size_t)shi * DM + 256 * j + 4 * lane); sc1[j] = *(const f32x4*)(mod + (size_t)b * 6 * DM + (size_t)(shi + 1) * DM + 256 * j + 4 * lane) + 1.f; } } } \
        const float mean = wave_sum(s) * (1.f / DM); float s2 = 0.f; \
        _Pragma("unroll") for (int j = 0; j < 8; ++j) { X[j] = X[j] - mean; s2 += (X[j].x * X[j].x + X[j].y * X[j].y) + (X[j].z * X[j].z + X[j].w * X[j].w); } \
        const float rstd = 1.f / sqrtf(wave_sum(s2) * (1.f / DM) + LN_EPS); \
        _Pragma("unroll") for (int j = 0; j < 8; ++j) { const f32x4 g_ = *(const LAS f32x4*)(gl + 256 * j + 4 * lane), b_ = *(const LAS f32x4*)(gl + DM + 256 * j + 4 * lane); \
            X[j] = X[j] * rstd * g_ + b_; const size_t o_ = (size_t)m * DM + 256 * j + 4 * lane; \
            if constexpr (XOUT_BF) { u32x2 ov_; ov_.x = cvtpk_bf16(X[j].x, X[j].y); ov_.y = cvtpk_bf16(X[j].z, X[j].w); *(u32x2*)((bf16*)xo_ + o_) = ov_; } else *(f32x4*)((float*)xo_ + o_) = X[j]; } \
        if constexpr (MODULATE) modulate_row<GATES>(P, lm, m, X, sc1, sh, lds, lane, bfl); } while (0)
    if (nrow > 0) LN_LOAD(xa, ya, 0);
#pragma unroll 1
    for (int i = 0; i < nrow; i += 2) {
        if (i + 1 < nrow) LN_LOAD(xb, yb, i + 1);
        LN_PROC(xa, ya, i);
        if (i + 1 >= nrow) break;
        if (i + 2 < nrow) LN_LOAD(xa, ya, i + 2);
        LN_PROC(xb, yb, i + 1);
    }
#undef LN_LOAD
#undef LN_PROC
}
__device__ __forceinline__ void scan_phase(const Params& P, LAS unsigned char* lds, int tid) {
    LAS double* part = (LAS double*)lds;
    const float* lf = (const float*)(P.ws + WS_LF); float* fb = (float*)(P.ws + WS_FB);
    const int lane = tid & 63, wv = tid >> 6;
    for (int q = blockIdx.x; q < BATCH * NFOX; q += gridDim.x) {
        const float* src = lf + (size_t)q * SEQ + tid * 8; double run = 0.0;
        const f32x4 a = *(const f32x4*)src, b = *(const f32x4*)(src + 4);
        double l0, l1, l2, l3, l4, l5, l6, l7;
        run += a.x; l0 = run; run += a.y; l1 = run; run += a.z; l2 = run; run += a.w; l3 = run;
        run += b.x; l4 = run; run += b.y; l5 = run; run += b.z; l6 = run; run += b.w; l7 = run;
        double inc = run;
#pragma unroll
        for (int o = 1; o < 64; o <<= 1) { const double t = __shfl_up(inc, o); if (lane >= o) inc += t; }
        if (lane == 63) part[wv] = inc;
        __syncthreads();
        double base = inc - run;
#pragma unroll
        for (int w = 0; w < NWAVES; ++w) if (w < wv) base += part[w];
        const double sc = -(double)FOX_INV_SCALE;
        f32x4 o0, o1;
        o0.x = (float)((base + l0) * sc); o0.y = (float)((base + l1) * sc); o0.z = (float)((base + l2) * sc); o0.w = (float)((base + l3) * sc);
        o1.x = (float)((base + l4) * sc); o1.y = (float)((base + l5) * sc); o1.z = (float)((base + l6) * sc); o1.w = (float)((base + l7) * sc);
        *(f32x4*)(fb + (size_t)q * SEQ + tid * 8) = o0; *(f32x4*)(fb + (size_t)q * SEQ + tid * 8 + 4) = o1;
        __syncthreads();
    }
}
__device__ __forceinline__ void combine_phase(const Params& P, int l, int gw, int NGW, int lane) {
    const float lam_init = 0.8f - 0.6f * expf(-0.3f * (float)l);
    const float d1 = wave_sum(P.lq1[l * 64 + lane] * P.lk1[l * 64 + lane]), d2 = wave_sum(P.lq2[l * 64 + lane] * P.lk2[l * 64 + lane]);
    const float lam = expf(d1) - expf(d2) + lam_init;
    const float* od = (const float*)(P.ws + WS_OD); bf16* mix = (bf16*)(P.ws + WS_MIX);
    const float g0 = P.subln_g[l * HD + 2 * lane] * (1.f - lam_init), g1 = P.subln_g[l * HD + 2 * lane + 1] * (1.f - lam_init);
    typedef float f32x2 __attribute__((ext_vector_type(2)));
#pragma unroll 1
    for (int m = gw; m < M; m += NGW) {
        const int b = m >> 12, s = m & (SEQ - 1);
        const float* base = od + (((size_t)b * 16) * SEQ + s) * HD + 2 * lane;
        f32x2 a[16];
#pragma unroll
        for (int v = 0; v < 16; ++v) a[v] = *(const f32x2*)(base + (size_t)v * SEQ * HD);
        float e0[8], e1[8], ms[8];
#pragma unroll
        for (int h = 0; h < 8; ++h) { e0[h] = a[2 * h].x - lam * a[2 * h + 1].x; e1[h] = a[2 * h].y - lam * a[2 * h + 1].y; ms[h] = e0[h] * e0[h] + e1[h] * e1[h]; }
#pragma unroll
        for (int o = 1; o < 64; o <<= 1) {
#pragma unroll
            for (int h = 0; h < 8; ++h) ms[h] += __shfl_xor(ms[h], o);
        }
#pragma unroll
        for (int h = 0; h < 8; ++h) { const float r = 1.f / sqrtf(ms[h] * (1.f / HD) + RMS_EPS);
            *(unsigned*)(mix + (size_t)m * DM + 1024 + h * HD + 2 * lane) = pk2(e0[h] * r * g0, e1[h] * r * g1); }
    }
}

struct EpiInProj {
    static constexpr bool PERM = true, AFTER_DRAIN = false;
    bf16* qkv; const float* rope;
    __device__ __forceinline__ static pg8::f32x4 xor16(pg8::f32x4 v, bool odd) {
        pg8::f32x4 r;
#pragma unroll
        for (int e = 0; e < 4; ++e) { auto s = __builtin_amdgcn_permlane16_swap(__float_as_uint(v[e]), __float_as_uint(v[e]), false, false); r[e] = __uint_as_float(odd ? s[0] : s[1]); }
        return r;
    }
    __device__ __forceinline__ void operator()(const pg8::f32x4 (&acc)[2][2][4][2], const pg8::Unit& u, int wr, int wc, int fr, int fq) const {
        const int seg = u.pn >> 2, cs0 = (u.pn & 3) * 256;
        bf16* base = qkv + (size_t)seg * ((size_t)M * 1024);
        const bool ropeseg = (seg == 3 || seg == 4), do_rope = ropeseg && ((wc & 1) == 0);
        const int rowb = u.pm * 256 + wr * 64 + fr;
        pg8::f32x4 nc0, nc1, ns0, ns1;
        if (do_rope) { const float* rp = rope + (size_t)rowb * 16; nc0 = *(const pg8::f32x4*)rp; nc1 = *(const pg8::f32x4*)(rp + 4); ns0 = *(const pg8::f32x4*)(rp + 8); ns1 = *(const pg8::f32x4*)(rp + 12); }
#pragma unroll
        for (int idx = 0; idx < 8; ++idx) {
                const int ai = idx >> 2, m = idx & 3;
                const int row = rowb + ai * 128 + m * 16, b = row >> 12, s = row & (SEQ - 1);
                const pg8::f32x4 c0 = nc0, c1 = nc1, s0 = ns0, s1 = ns1;
                if (do_rope && idx < 7) { const int rn = rowb + ((idx + 1) >> 2) * 128 + ((idx + 1) & 3) * 16; const float* rp = rope + (size_t)rn * 16;
                    nc0 = *(const pg8::f32x4*)rp; nc1 = *(const pg8::f32x4*)(rp + 4); ns0 = *(const pg8::f32x4*)(rp + 8); ns1 = *(const pg8::f32x4*)(rp + 12); }
#pragma unroll
                for (int bj = 0; bj < 2; ++bj) {
                    const int cs = cs0 + bj * 128 + wc * 32 + 8 * fq;
                    pg8::f32x4 v0 = acc[ai][bj][m][0], v1 = acc[ai][bj][m][1];
                    if (do_rope) {
                        const pg8::f32x4 p0 = xor16(v0, fq & 1), p1 = xor16(v1, fq & 1);
                        if (fq < 2) { const float sg = fq == 0 ? -1.f : 1.f; v0 = v0 * c0 + (p0 * s0) * sg; v1 = v1 * c1 + (p1 * s1) * sg; }
                    }
                    pg8::u32x4 w; w.x = pg8::cvt_pk_bf16(v0[0], v0[1]); w.y = pg8::cvt_pk_bf16(v0[2], v0[3]); w.z = pg8::cvt_pk_bf16(v1[0], v1[1]); w.w = pg8::cvt_pk_bf16(v1[2], v1[3]);
                    bf16* dst = ropeseg ? base + (((size_t)(b * 16 + (cs >> 6)) * SEQ + s) * 64 + (cs & 63))
                                        : base + (((size_t)(b * 8 + (cs >> 7)) * SEQ + s) * 128 + (cs & 127));
                    *(pg8::u32x4*)dst = w;
                }
        }
    }
};
struct EpiRelu2 {
    static constexpr bool PERM = true, AFTER_DRAIN = false;
    bf16* U;
    __device__ __forceinline__ void operator()(const pg8::f32x4 (&acc)[2][2][4][2], const pg8::Unit& u, int wr, int wc, int fr, int fq) const {
        const int row0 = u.pm * 256 + wr * 64 + fr, col0 = u.pn * 256 + wc * 32 + 8 * fq;
#pragma unroll
        for (int ai = 0; ai < 2; ++ai)
#pragma unroll
            for (int m = 0; m < 4; ++m) { bf16* rowp = U + (size_t)(row0 + ai * 128 + m * 16) * DFF + col0;
#pragma unroll
                for (int bj = 0; bj < 2; ++bj) { pg8::f32x4 v0 = acc[ai][bj][m][0], v1 = acc[ai][bj][m][1];
#pragma unroll
                    for (int e = 0; e < 4; ++e) { const float a = fmaxf(v0[e], 0.f), c = fmaxf(v1[e], 0.f); v0[e] = a * a; v1[e] = c * c; }
                    pg8::u32x4 w; w.x = pg8::cvt_pk_bf16(v0[0], v0[1]); w.y = pg8::cvt_pk_bf16(v0[2], v0[3]); w.z = pg8::cvt_pk_bf16(v1[0], v1[1]); w.w = pg8::cvt_pk_bf16(v1[2], v1[3]);
                    *(pg8::u32x4*)(rowp + bj * 128) = w; } }
    }
};
struct EpiGate {
    static constexpr bool PERM = true, AFTER_DRAIN = false;
    bf16* Y; const float* gate;
    __device__ __forceinline__ void operator()(const pg8::f32x4 (&acc)[2][2][4][2], const pg8::Unit& u, int wr, int wc, int fr, int fq) const {
        const int row0 = u.pm * 256 + wr * 64 + fr, col0 = u.pn * 256 + wc * 32 + 8 * fq, b = (u.pm * 256) >> 12;
        pg8::f32x4 gv[2][2];
#pragma unroll
        for (int bj = 0; bj < 2; ++bj)
#pragma unroll
            for (int n = 0; n < 2; ++n) gv[bj][n] = *(const pg8::f32x4*)(gate + (size_t)b * 6 * DM + col0 + bj * 128 + 4 * n) + 1.f;
#pragma unroll
        for (int ai = 0; ai < 2; ++ai)
#pragma unroll
            for (int m = 0; m < 4; ++m) { bf16* rowp = Y + (size_t)(row0 + ai * 128 + m * 16) * DM + col0;
#pragma unroll
                for (int bj = 0; bj < 2; ++bj) { const pg8::f32x4 v0 = acc[ai][bj][m][0] * gv[bj][0], v1 = acc[ai][bj][m][1] * gv[bj][1];
                    pg8::u32x4 w; w.x = pg8::cvt_pk_bf16(v0[0], v0[1]); w.y = pg8::cvt_pk_bf16(v0[2], v0[3]); w.z = pg8::cvt_pk_bf16(v1[0], v1[1]); w.w = pg8::cvt_pk_bf16(v1[2], v1[3]);
                    *(pg8::u32x4*)(rowp + bj * 128) = w; } }
    }
};

template <int DQK, bool BIAS, class TOut, int OST> struct AttnRef {
    unsigned char* ws; int jlo0, jlo1; float lam, gmul; const float* gsub;
    __device__ __forceinline__ int jlo_of(int step) const { return step ? jlo1 : jlo0; }
    __device__ __forceinline__ att::BlockRef<TOut> operator()(int L, int step) const {
        const int bh = 4 * (L & 7) + (L >> 6), x = (L >> 3) & 7;
        att::BlockRef<TOut> r;
        const bf16* qkv = (const bf16*)(ws + WS_QKV); const size_t SEG = (size_t)M * 1024;
        const int b = bh >> 3, h = bh & 7;
        if constexpr (BIAS) {
            const int qb = step ? 15 - x : x;
            r.Q = qkv + ((size_t)bh * SEQ + (size_t)qb * 256) * 128; r.K = qkv + SEG + (size_t)bh * SEQ * 128; r.V = qkv + 2 * SEG + (size_t)bh * SEQ * 128;
            r.Fb = (const float*)(ws + WS_FB) + (size_t)bh * SEQ;
            r.O = (TOut*)(ws + WS_MIX) + ((size_t)b * SEQ + (size_t)qb * 256) * OST + h * 128; r.MX = nullptr; r.comp = 0; r.P0 = qb * 256;
        } else {
            const int comp = step & 1, qb = (step >> 1) ? 15 - x : x, vh = b * 16 + 2 * h + comp;
            r.Q = qkv + 3 * SEG + ((size_t)vh * SEQ + (size_t)qb * 256) * 64; r.K = qkv + 4 * SEG + (size_t)vh * SEQ * 64; r.V = qkv + 5 * SEG + (size_t)bh * SEQ * 128;
            r.Fb = nullptr;
            r.O = (TOut*)(ws + WS_OD) + ((size_t)bh * SEQ + (size_t)qb * 256) * OST;
            r.MX = (bf16*)(ws + WS_MIX) + ((size_t)b * SEQ + (size_t)qb * 256) * DM + 1024 + h * 128; r.comp = comp; r.P0 = qb * 256;
        }
        return r;
    }
};
__device__ __forceinline__ float rows_maxnorm2(const bf16* base, int nrows, float* scr, int tid) {
    const int lane = tid & 63, wid = tid >> 6;
    float mx = 0.f;
    for (int r0 = wid * 4; r0 < nrows; r0 += 8 * 4 * 32) {
        u32x4 v[32];
#pragma unroll
        for (int i = 0; i < 32; ++i) { const int r = r0 + 32 * i + (lane >> 4); v[i] = (r < nrows) ? *(const u32x4*)(base + (size_t)r * 128 + (lane & 15) * 8) : (u32x4){0u, 0u, 0u, 0u}; }
#pragma unroll
        for (int i = 0; i < 32; ++i) { float s = 0.f;
#pragma unroll
            for (int e = 0; e < 4; ++e) { const float lo = __uint_as_float(v[i][e] << 16), hi = __uint_as_float(v[i][e] & 0xffff0000u); s += lo * lo + hi * hi; }
            mx = fmaxf(mx, att::row16_sum(s)); }
    }
    __syncthreads();
    if ((lane & 15) == 0) scr[wid * 4 + (lane >> 4)] = mx;
    __syncthreads();
    float r = scr[0];
#pragma unroll
    for (int w = 1; w < NWAVES * 4; ++w) r = fmaxf(r, scr[w]);
    return r;
}
__device__ __forceinline__ void rows_qstats(const bf16* qrows, const bf16* krows, float* scr, int tid, float& dmin, float& q2max) {
    const int lane = tid & 63, wid = tid >> 6;
    float mn = 3.0e38f, mx = 0.f;
    u32x4 qv[8], kv[8];
#pragma unroll
    for (int i = 0; i < 8; ++i) { const int r = wid * 32 + 4 * i + (lane >> 4); qv[i] = *(const u32x4*)(qrows + (size_t)r * 128 + (lane & 15) * 8); kv[i] = *(const u32x4*)(krows + (size_t)r * 128 + (lane & 15) * 8); }
#pragma unroll
    for (int i = 0; i < 8; ++i) { float s = 0.f, n = 0.f;
#pragma unroll
        for (int e = 0; e < 4; ++e) { const float ql = __uint_as_float(qv[i][e] << 16), qh = __uint_as_float(qv[i][e] & 0xffff0000u);
            s += ql * __uint_as_float(kv[i][e] << 16) + qh * __uint_as_float(kv[i][e] & 0xffff0000u); n += ql * ql + qh * qh; }
        mn = fminf(mn, att::row16_sum(s)); mx = fmaxf(mx, att::row16_sum(n)); }
    __syncthreads();
    if ((lane & 15) == 0) { scr[wid * 4 + (lane >> 4)] = mn; scr[32 + wid * 4 + (lane >> 4)] = mx; }
    __syncthreads();
    float r0 = scr[0], r1 = scr[32];
#pragma unroll
    for (int w = 1; w < NWAVES * 4; ++w) { r0 = fminf(r0, scr[w]); r1 = fmaxf(r1, scr[32 + w]); }
    dmin = r0; q2max = r1;
}
template <int DQK, bool BIAS, class TOut, int OST>
__device__ __forceinline__ void attn_stream(const Params& P, int l, char* lds, int total) {
    int L = blockIdx.x; if (L >= total) return;
    const int stride = gridDim.x;
    AttnRef<DQK, BIAS, TOut, OST> rf{P.ws, 0, 0, 0.f, 0.f, nullptr};
    att::Seam<DQK> S;
    if constexpr (BIAS) {
        for (;;) {
            { const int tid = ltid(); float* scr = (float*)(lds + att::OFF_WS);
              const att::BlockRef<TOut> b0 = rf(L, 0), b1 = rf(L, 1);
              const float kmax = sqrtf(rows_maxnorm2(b0.K, b1.P0 + 256, scr, tid)) * 1.0001f;
              float d0, d1, q20, q21;
              rows_qstats(b0.Q, b0.K + (size_t)b0.P0 * 128, scr, tid, d0, q20); rows_qstats(b1.Q, b1.K + (size_t)b1.P0 * 128, scr, tid, d1, q21);
              const float q0 = sqrtf(q20) * 1.0001f, q1 = sqrtf(q21) * 1.0001f;
              const float thr0 = q0 * kmax - d0 + fabsf(d0) * 1e-4f + 24.f * FOX_INV_SCALE, thr1 = q1 * kmax - d1 + fabsf(d1) * 1e-4f + 24.f * FOX_INV_SCALE;
              rf.jlo0 = att::fox_jlo(b0.Fb, b0.P0, thr0, tid & 63); rf.jlo1 = att::fox_jlo(b1.Fb, b1.P0, thr1, tid & 63);
              __syncthreads(); }
            { const att::BlockRef<TOut> cur = rf(L, 0); att::causal_prime<DQK, BIAS, TOut>(cur, rf.jlo0, lds, S); }
            att::causal_block<DQK, BIAS, TOut, OST>(rf, L, 0, L, 1, lds, S);
            att::causal_block<DQK, BIAS, TOut, OST>(rf, L, 1, L, 1, lds, S);
            if (L + stride >= total) break;
            L += stride; __syncthreads();
        }
    } else {
        { const int lane = ltid() & 63;
          const float lam_init = 0.8f - 0.6f * expf(-0.3f * (float)l);
          const float d1 = wave_sum(P.lq1[l * 64 + lane] * P.lk1[l * 64 + lane]), d2 = wave_sum(P.lq2[l * 64 + lane] * P.lk2[l * 64 + lane]);
          rf.lam = expf(d1) - expf(d2) + lam_init; rf.gmul = 1.f - lam_init; rf.gsub = P.subln_g + l * HD; }
        { const att::BlockRef<TOut> cur = rf(L, 0); att::causal_prime<DQK, BIAS, TOut>(cur, 0, lds, S); }
        int step = 0;
#pragma unroll 1
        for (;;) {
            int Ln = L, sn = step + 1;
            if (sn == 4) { if (L + stride < total) { Ln = L + stride; sn = 0; } else { sn = 3; } }
            const bool last = (step == 3) && (Ln == L);
            att::causal_block<DQK, BIAS, TOut, OST>(rf, L, step, Ln, sn, lds, S);
            if (last) break;
            L = Ln; step = sn;
        }
    }
}

#ifndef REP_LN1
#define REP_LN1 1
#endif
#ifndef REP_LN2
#define REP_LN2 1
#endif
#ifndef REP_P0
#define REP_P0 1
#endif
#ifndef REP_CV
#define REP_CV 1
#endif
#ifndef REP_MG
#define REP_MG 1
#endif
#ifndef REP_R
#define REP_R 1
#endif
#ifndef REP_S
#define REP_S 1
#endif
#define GSYNC() do { for (int rs_ = 0; rs_ < REP_S; ++rs_) xcd_barrier(xbar); } while (0)
#ifndef REP_G
#define REP_G 1
#endif
#ifndef REP_FOX
#define REP_FOX 1
#endif
#ifndef REP_A
#define REP_A 1
#endif
__device__ __forceinline__ Params load_params() {
#if defined(__HIP_DEVICE_COMPILE__)
    typedef const __attribute__((address_space(4))) Params* CP;
    CP p = (CP)__builtin_amdgcn_kernarg_segment_ptr();
    asm volatile("" : "+s"(p));
    return *p;
#else
    return Params{};
#endif
}
__global__ void __launch_bounds__(NTHREADS) fwd_megakernel(Params P_arg) {
    extern __shared__ __attribute__((aligned(16))) unsigned char lds_raw[];
    cg::grid_group grid = cg::this_grid();
    LAS unsigned char* lds = (LAS unsigned char*)lds_raw;
    const int G = gridDim.x, NGW = G * NWAVES;
    volatile LAS unsigned* xb_st = (volatile LAS unsigned*)(lds + 131072 + 256);
    if (threadIdx.x < 2) xb_st[threadIdx.x] = 0u;
    __syncthreads();
    XcdBarrier xbar;
    { const Params P = load_params(); xbar = xcd_barrier_post((unsigned*)(P.ws + WS_BAR), xb_st); }
#define PH_IDS() const Params P = load_params(); unsigned char* ws = P.ws; (void)ws; const int tid = ltid(), lane = tid & 63, wave = __builtin_amdgcn_readfirstlane(tid >> 6), gw = blockIdx.x * NWAVES + wave; (void)lane; (void)gw

    for (int rr_ = 0; rr_ < REP_R * REP_P0; ++rr_) { PH_IDS(); adaln_phase(P, lds, tid); }
    for (int rr_ = 0; rr_ < REP_R; ++rr_) { PH_IDS(); rope_phase(P, blockIdx.x * NTHREADS + tid, G * NTHREADS); }
    for (int rr_ = 0; rr_ < REP_R * REP_P0; ++rr_) { PH_IDS(); convert_weights(P, 0, lds, gw, NGW, wave, lane); }
    grid.sync();
    for (int rr_ = 0; rr_ < REP_R * REP_MG; ++rr_) { PH_IDS(); modgate_phase(P, 0, P.x, lds, gw, NGW, lane); }
    GSYNC();

#pragma unroll 1
    for (int l = 0; l < DEPTH; ++l) {
        for (int rr_ = 0; rr_ < REP_R; ++rr_) { PH_IDS(); scan_phase(P, lds, tid); }
        __syncthreads();
#ifndef NO_G1
        for (int rep_ = 0; rep_ < REP_G; ++rep_)
        { const Params P = load_params(); unsigned char* ws = P.ws;
          pg8::Gemm g{(const pg8::bf16_t*)(ws + WS_H), (const pg8::bf16_t*)(ws + WS_WIN), M, NQKV, DM}; pg8::StaticOrder S; S.init(M, NQKV, G, (int)blockIdx.x);
          EpiInProj E{(bf16*)(ws + WS_QKV), (const float*)(ws + WS_ROPE)};
          pg8::gemm_phase<EpiInProj, pg8::StaticOrder, true, true>(lds, g, S, E); }
#endif
        GSYNC();
        for (int rep_ = 0; rep_ < REP_A; ++rep_) {
#ifndef NO_A1
        for (int rf_ = 0; rf_ < REP_FOX; ++rf_) { const Params P = load_params(); attn_stream<128, true, bf16, DM>(P, l, (char*)lds_raw, BATCH * NFOX * 8); __syncthreads(); }
#endif
        __syncthreads();
#ifndef NO_A2
        { const Params P = load_params(); attn_stream<64, false, float, 128>(P, l, (char*)lds_raw, BATCH * NDIFF * 8); }
#endif
        __syncthreads(); }
        GSYNC();
#ifndef NO_G2
        for (int rep_ = 0; rep_ < REP_G; ++rep_)
        { const Params P = load_params(); unsigned char* ws = P.ws; const float* modl = (const float*)(ws + WS_MOD) + (size_t)l * BATCH * 6 * DM;
          pg8::Gemm g{(const pg8::bf16_t*)(ws + WS_MIX), (const pg8::bf16_t*)(ws + WS_WO), M, DM, DM}; pg8::StaticOrder S; S.init(M, DM, G, (int)blockIdx.x);
          EpiGate E{(bf16*)(ws + WS_Z), modl + 2 * DM};
          pg8::gemm_phase<EpiGate, pg8::StaticOrder, true, true>(lds, g, S, E); }
#endif
        GSYNC();
        for (int rr_ = 0; rr_ < REP_R * REP_LN1; ++rr_) { PH_IDS();
            if (l == 0) ln_phase<false, true, false, true>(P, P.x, (const bf16*)(ws + WS_Z), P.ln1_g + l * DM, P.ln1_b + l * DM, ws + WS_XA, l, 3, lds, gw, NGW, lane);
            else        ln_phase<false, true, true, true>(P, ws + WS_X2, (const bf16*)(ws + WS_Z), P.ln1_g + l * DM, P.ln1_b + l * DM, ws + WS_XA, l, 3, lds, gw, NGW, lane); }
        GSYNC();
#ifndef NO_G3
        for (int rep_ = 0; rep_ < REP_G; ++rep_)
        { const Params P = load_params(); unsigned char* ws = P.ws;
          pg8::Gemm g{(const pg8::bf16_t*)(ws + WS_H), (const pg8::bf16_t*)(ws + WS_WUP), M, DFF, DM}; pg8::StaticOrder S; S.init(M, DFF, G, (int)blockIdx.x);
          EpiRelu2 E{(bf16*)(ws + WS_U)};
          pg8::gemm_phase<EpiRelu2, pg8::StaticOrder, true, true>(lds, g, S, E); }
#endif
        GSYNC();
#ifndef NO_G4
        for (int rep_ = 0; rep_ < REP_G; ++rep_)
        { const Params P = load_params(); unsigned char* ws = P.ws; const float* modl = (const float*)(ws + WS_MOD) + (size_t)l * BATCH * 6 * DM;
          pg8::Gemm g{(const pg8::bf16_t*)(ws + WS_U), (const pg8::bf16_t*)(ws + WS_WDN), M, DM, DFF}; pg8::StaticOrder S; S.init(M, DM, G, (int)blockIdx.x);
          EpiGate E{(bf16*)(ws + WS_Z), modl + 5 * DM};
          pg8::gemm_phase<EpiGate, pg8::StaticOrder, true, true>(lds, g, S, E); }
#endif
        GSYNC();
        if (l + 1 < DEPTH) {
            for (int rr_ = 0; rr_ < REP_R * REP_CV; ++rr_) { PH_IDS(); convert_weights(P, l + 1, lds, gw, NGW, wave, lane); }
            __syncthreads();
            for (int rr_ = 0; rr_ < REP_R * REP_LN2; ++rr_) { PH_IDS(); ln_phase<true, true, true, true>(P, ws + WS_XA, (const bf16*)(ws + WS_Z), P.ln2_g + l * DM, P.ln2_b + l * DM, ws + WS_X2, l + 1, 0, lds, gw, NGW, lane); }
            GSYNC();
        } else {
            for (int rr_ = 0; rr_ < REP_R * REP_LN2; ++rr_) { PH_IDS(); ln_phase<false, false, true, false>(P, ws + WS_XA, (const bf16*)(ws + WS_Z), P.ln2_g + l * DM, P.ln2_b + l * DM, P.out, l, 0, lds, gw, NGW, lane); }
        }
    }
}

extern "C" void kernel_launch(void* const* d_in, const int* in_sizes, int n_in, void* d_out, int out_size, void* d_ws, size_t ws_size, hipStream_t stream) {
    static int grid = 0;
    if (grid == 0) {
        if (n_in != 19 || in_sizes[0] != M * DM || out_size != M * DM || ws_size < WS_END) {
            fprintf(stderr, "kernel_launch: unexpected shapes (n_in %d, in0 %d, out %d, ws %zu; need ws >= %zu); nothing launched\n", n_in, n_in > 0 ? in_sizes[0] : -1, out_size, ws_size, (size_t)WS_END);
            grid = -1; return; }
        int dev = 0, cus = 0, per_cu = 0;
        (void)hipGetDevice(&dev);
        (void)hipDeviceGetAttribute(&cus, hipDeviceAttributeMultiprocessorCount, dev);
        if (hipFuncSetAttribute((const void*)fwd_megakernel, hipFuncAttributeMaxDynamicSharedMemorySize, LDS_BYTES) != hipSuccess) { fprintf(stderr, "kernel_launch: hipFuncSetAttribute failed\n"); grid = -1; return; }
        if (hipOccupancyMaxActiveBlocksPerMultiprocessor(&per_cu, (const void*)fwd_megakernel, NTHREADS, LDS_BYTES) != hipSuccess || per_cu < 1) { fprintf(stderr, "kernel_launch: occupancy query says %d\n", per_cu); per_cu = 1; }
        (void)hipGetLastError();
        grid = cus * per_cu;
        if (grid <= 0) grid = 256;
    }
    if (grid < 0) return;
    Params p{};
    p.x = (const float*)d_in[0]; p.c = (const float*)d_in[1]; p.pos = (const int*)d_in[2]; p.w_ada = (const float*)d_in[3]; p.b_ada = (const float*)d_in[4];
    p.w_in = (const float*)d_in[5]; p.b_f = (const float*)d_in[6]; p.lq1 = (const float*)d_in[7]; p.lk1 = (const float*)d_in[8]; p.lq2 = (const float*)d_in[9];
    p.lk2 = (const float*)d_in[10]; p.subln_g = (const float*)d_in[11]; p.w_o = (const float*)d_in[12]; p.ln1_g = (const float*)d_in[13]; p.ln1_b = (const float*)d_in[14];
    p.w_up = (const float*)d_in[15]; p.w_down = (const float*)d_in[16]; p.ln2_g = (const float*)d_in[17]; p.ln2_b = (const float*)d_in[18];
    p.out = (float*)d_out; p.ws = (unsigned char*)d_ws;
    if (hipMemsetAsync((char*)d_ws + WS_BAR, 0, 16384, stream) != hipSuccess) { fprintf(stderr, "kernel_launch: hipMemsetAsync failed\n"); return; }
    void* args[] = {&p};
    hipError_t e = hipLaunchCooperativeKernel((const void*)fwd_megakernel, dim3(grid), dim3(NTHREADS), args, LDS_BYTES, stream);
    if (e != hipSuccess) fprintf(stderr, "kernel_launch: cooperative launch failed: %s (grid %d)\n", hipGetErrorString(e), grid);
}
```
